# Optimizing an MI355X kernel written in HIP

```python
import math
import jax, jax.numpy as jnp
from jax import lax
import numpy as np

D_MODEL = 1024
BATCH = 1
SEQ = 16384
DEPTH = 2

CHUNK = 64
EPS = 1e-6
F32 = jnp.float32

SC_WIDTH = 512
SC_KERNEL = 3
SSM_D_INNER = 1024
SSM_HEAD_DIM = 64
SSM_HEADS = SSM_D_INNER // SSM_HEAD_DIM
SSM_GROUPS = 4
SSM_STATE = 128
SSM_CONV = 4
SSM_CONV_DIM = SSM_D_INNER + 2 * SSM_GROUPS * SSM_STATE
GM_WIDTH = 512
GM_GROUPS = 4
GM_BLOCK = 128
GM_GROUP_DIM = GM_WIDTH // GM_GROUPS
POOL_WIDTH = 512
POOL_WINDOWS = (2, 4, 8, 16)
POOL_GROUP = POOL_WIDTH // len(POOL_WINDOWS)
N_BRANCH = 4
IN_A = 3 * SC_WIDTH
IN_B = SSM_D_INNER + SSM_CONV_DIM + SSM_HEADS
IN_C = 2 * GM_WIDTH
IN_D = POOL_WIDTH
IN_TOTAL = IN_A + IN_B + IN_C + IN_D
D_FF = 2816
N_EXPERTS = 8
TOP_K = 2
D_FF_EXPERT = 3584
N_DENSE = (DEPTH + 1) // 2
N_MOE = DEPTH // 2

kernel_name = "hybrid_parallel_gated_mixers_moe"


def rmsnorm(x, g):
    xf = x.astype(F32)
    y = xf * lax.rsqrt(jnp.mean(xf * xf, -1, keepdims=True) + EPS)
    return (y * g.astype(F32)).astype(x.dtype)


def causal_dwconv(x, w):
    k = w.shape[0]
    L = x.shape[1]
    xp = jnp.pad(x, ((0, 0), (k - 1, 0), (0, 0)))
    return sum(xp[:, i:i + L] * w[i] for i in range(k))


def short_conv_mixer(h, b_gate, c_gate, conv_w):
    return b_gate * causal_dwconv(c_gate * h, conv_w)


def segsum_exp(a):
    cs = jnp.cumsum(a, -1)
    diff = cs[..., :, None] - cs[..., None, :]
    l = a.shape[-1]
    mask = jnp.tril(jnp.ones((l, l), bool))
    return jnp.exp(jnp.where(mask, diff, -jnp.inf))


def ssd_scan(x, dt, a, bmat, cmat):
    bsz, L, H, P = x.shape
    G, N = bmat.shape[-2:]
    K = H // G
    nc = L // CHUNK
    xdt = (x.astype(F32) * dt[..., None]).reshape(bsz, nc, CHUNK, G, K, P)
    da = jnp.moveaxis((dt * a).reshape(bsz, nc, CHUNK, G, K), 2, -1)
    bc = bmat.astype(F32).reshape(bsz, nc, CHUNK, G, N)
    cc = cmat.astype(F32).reshape(bsz, nc, CHUNK, G, N)
    da_cs = jnp.cumsum(da, -1)
    cb = jnp.einsum("bclgn,bcsgn->bcgls", cc, bc)
    scores = cb[:, :, :, None] * segsum_exp(da)
    y_diag = jnp.einsum("bcgkls,bcsgkp->bclgkp", scores, xdt)
    decay_to_end = jnp.exp(da_cs[..., -1:] - da_cs)
    states = jnp.einsum("bclgn,bcgkl,bclgkp->bcgkpn", bc, decay_to_end, xdt)
    chunk_decay = jnp.exp(da_cs[..., -1])

    def step(h, inp):
        s_c, d_c = inp
        return h * d_c[..., None, None] + s_c, h

    h0 = jnp.zeros((bsz, G, K, P, N), F32)
    _, h_in = lax.scan(step, h0, (jnp.moveaxis(states, 1, 0), jnp.moveaxis(chunk_decay, 1, 0)))
    h_in = jnp.moveaxis(h_in, 0, 1)
    y_off = jnp.einsum("bclgn,bcgkpn,bcgkl->bclgkp", cc, h_in, jnp.exp(da_cs))
    return (y_diag + y_off).reshape(bsz, L, H, P)


def mamba2_mixer(z, xbc, dt_raw, conv_w, conv_b, dt_bias, a_log, d_skip, norm_g):
    bsz, L, _ = z.shape
    xbc = jax.nn.silu(causal_dwconv(xbc, conv_w) + conv_b)
    xs, bm, cm = jnp.split(xbc, [SSM_D_INNER, SSM_D_INNER + SSM_GROUPS * SSM_STATE], -1)
    xs = xs.reshape(bsz, L, SSM_HEADS, SSM_HEAD_DIM)
    bm = bm.reshape(bsz, L, SSM_GROUPS, SSM_STATE)
    cm = cm.reshape(bsz, L, SSM_GROUPS, SSM_STATE)
    dt = jax.nn.softplus(dt_raw.astype(F32) + dt_bias.astype(F32))
    a = -jnp.exp(a_log.astype(F32))
    y = ssd_scan(xs, dt, a, bm, cm) + xs.astype(F32) * d_skip.astype(F32)[:, None]
    y = y.reshape(bsz, L, SSM_D_INNER) * jax.nn.silu(z.astype(F32))
    yg = y.reshape(bsz, L, SSM_GROUPS, -1)
    yg = yg * lax.rsqrt(jnp.mean(yg * yg, -1, keepdims=True) + EPS)
    return (yg.reshape(bsz, L, SSM_D_INNER) * norm_g.astype(F32)).astype(z.dtype)


def gmlp_mixer(uv, ln_g, ln_b, w_s, s_bias):
    uv = jax.nn.gelu(uv)
    u, v = jnp.split(uv, 2, -1)
    vf = v.astype(F32)
    mu = jnp.mean(vf, -1, keepdims=True)
    var = jnp.mean(jnp.square(vf - mu), -1, keepdims=True)
    vf = (vf - mu) * lax.rsqrt(var + EPS) * ln_g.astype(F32) + ln_b.astype(F32)
    bsz, L, _ = v.shape
    nb = L // GM_BLOCK
    vf = vf.reshape(bsz, nb, GM_BLOCK, GM_GROUPS, GM_GROUP_DIM)
    mask = jnp.tril(jnp.ones((GM_BLOCK, GM_BLOCK), bool))
    ws = jnp.where(mask, w_s.astype(F32), 0.0)
    s = jnp.einsum("gts,bnsgc->bntgc", ws, vf) + s_bias.astype(F32).T[None, None, :, :, None]
    return u * s.reshape(bsz, L, GM_WIDTH).astype(u.dtype)


def pool_mixer(p, w_map, scale):
    bsz, L, _ = p.shape
    pf = p.astype(F32)
    count_base = jnp.arange(1, L + 1, dtype=F32)[None, :, None]
    outs = []
    for gi, w in enumerate(POOL_WINDOWS):
        xg = pf[..., gi * POOL_GROUP:(gi + 1) * POOL_GROUP]
        cs = jnp.cumsum(xg, 1)
        lag = jnp.pad(cs[:, :-w], ((0, 0), (w, 0), (0, 0)))
        outs.append((cs - lag) / jnp.minimum(count_base, w) - xg)
    pooled = jnp.stack(outs, 2)
    y = jnp.einsum("blgc,gcd->blgd", pooled, w_map.astype(F32)).reshape(bsz, L, POOL_WIDTH)
    return (y * scale.astype(F32)).astype(p.dtype)


def swiglu(x, wg, wu, wd):
    return (jax.nn.silu(x @ wg) * (x @ wu)) @ wd


def moe_ffn(x, router_w, wg, wu, wd):
    bsz, L, D = x.shape
    xt = x.reshape(-1, D)
    logits = (xt @ router_w).astype(F32)
    top_vals, top_idx = lax.top_k(logits, TOP_K)
    gates = jax.nn.softmax(top_vals, -1)
    combine = jnp.sum(jax.nn.one_hot(top_idx, N_EXPERTS, dtype=F32) * gates[..., None], 1)
    out = jnp.zeros(xt.shape, F32)
    for e in range(N_EXPERTS):
        out = out + combine[:, e:e + 1] * swiglu(xt, wg[e], wu[e], wd[e]).astype(F32)
    return out.astype(x.dtype).reshape(bsz, L, D)


def setup_inputs(seed: int = 0) -> dict:
    key = jax.random.key(seed)
    ks = iter(jax.random.split(key, 48))
    D = D_MODEL

    def nrm(shape, scale):
        return jax.random.normal(next(ks), shape, F32) * scale

    def gain(shape):
        return 1.0 + nrm(shape, 0.05)

    x = nrm((BATCH, SEQ, D), 1.0)
    norm1_g = gain((DEPTH, D))
    w_in = nrm((DEPTH, D, IN_TOTAL), D ** -0.5)
    w_gate = nrm((DEPTH, D, N_BRANCH * D), D ** -0.5)
    sc_conv_w = nrm((DEPTH, SC_KERNEL, SC_WIDTH), SC_KERNEL ** -0.5)
    ssm_conv_w = nrm((DEPTH, SSM_CONV, SSM_CONV_DIM), SSM_CONV ** -0.5)
    ssm_conv_b = nrm((DEPTH, SSM_CONV_DIM), 0.01)
    dt0 = jnp.exp(jax.random.uniform(next(ks), (DEPTH, SSM_HEADS), F32, math.log(1e-3), math.log(1e-1)))
    ssm_dt_bias = dt0 + jnp.log(-jnp.expm1(-dt0))
    ssm_a_log = jnp.log(jax.random.uniform(next(ks), (DEPTH, SSM_HEADS), F32, 1.0, 16.0))
    ssm_d = gain((DEPTH, SSM_HEADS))
    ssm_norm_g = gain((DEPTH, SSM_D_INNER))
    gm_ln_g = gain((DEPTH, GM_WIDTH))
    gm_ln_b = nrm((DEPTH, GM_WIDTH), 0.01)
    gm_ws = nrm((DEPTH, GM_GROUPS, GM_BLOCK, GM_BLOCK), GM_BLOCK ** -0.5)
    gm_bias = gain((DEPTH, GM_GROUPS, GM_BLOCK))
    pool_map = nrm((DEPTH, len(POOL_WINDOWS), POOL_GROUP, POOL_GROUP), POOL_GROUP ** -0.5)
    pool_scale = gain((DEPTH, POOL_WIDTH))
    w_br_a = nrm((DEPTH, SC_WIDTH, D), SC_WIDTH ** -0.5)
    w_br_b = nrm((DEPTH, SSM_D_INNER, D), SSM_D_INNER ** -0.5)
    w_br_c = nrm((DEPTH, GM_WIDTH, D), GM_WIDTH ** -0.5)
    w_br_d = nrm((DEPTH, POOL_WIDTH, D), POOL_WIDTH ** -0.5)
    w_out = nrm((DEPTH, D, D), D ** -0.5)
    norm2_g = gain((DEPTH, D))
    ffn_wg = nrm((N_DENSE, D, D_FF), D ** -0.5)
    ffn_wu = nrm((N_DENSE, D, D_FF), D ** -0.5)
    ffn_wd = nrm((N_DENSE, D_FF, D), D_FF ** -0.5)
    router_w = nrm((N_MOE, D, N_EXPERTS), D ** -0.5)
    moe_wg = nrm((N_MOE, N_EXPERTS, D, D_FF_EXPERT), D ** -0.5)
    moe_wu = nrm((N_MOE, N_EXPERTS, D, D_FF_EXPERT), D ** -0.5)
    moe_wd = nrm((N_MOE, N_EXPERTS, D_FF_EXPERT, D), D_FF_EXPERT ** -0.5)
    final_g = gain((D,))
    return {"x": x, "norm1_g": norm1_g, "w_in": w_in, "w_gate": w_gate,
            "sc_conv_w": sc_conv_w, "ssm_conv_w": ssm_conv_w, "ssm_conv_b": ssm_conv_b,
            "ssm_dt_bias": ssm_dt_bias, "ssm_a_log": ssm_a_log, "ssm_d": ssm_d,
            "ssm_norm_g": ssm_norm_g, "gm_ln_g": gm_ln_g, "gm_ln_b": gm_ln_b,
            "gm_ws": gm_ws, "gm_bias": gm_bias, "pool_map": pool_map,
            "pool_scale": pool_scale, "w_br_a": w_br_a, "w_br_b": w_br_b,
            "w_br_c": w_br_c, "w_br_d": w_br_d, "w_out": w_out, "norm2_g": norm2_g,
            "ffn_wg": ffn_wg, "ffn_wu": ffn_wu, "ffn_wd": ffn_wd, "router_w": router_w,
            "moe_wg": moe_wg, "moe_wu": moe_wu, "moe_wd": moe_wd, "final_g": final_g}


def reference(x, norm1_g, w_in, w_gate, sc_conv_w, ssm_conv_w, ssm_conv_b, ssm_dt_bias,
              ssm_a_log, ssm_d, ssm_norm_g, gm_ln_g, gm_ln_b, gm_ws, gm_bias, pool_map,
              pool_scale, w_br_a, w_br_b, w_br_c, w_br_d, w_out, norm2_g, ffn_wg, ffn_wu,
              ffn_wd, router_w, moe_wg, moe_wu, moe_wd, final_g):
    bsz, L, D = x.shape
    for layer in range(DEPTH):
        h = rmsnorm(x, norm1_g[layer])
        proj = h @ w_in[layer]
        pa, pb, pc, pd = jnp.split(proj, [IN_A, IN_A + IN_B, IN_A + IN_B + IN_C], -1)
        a_h, a_b, a_c = jnp.split(pa, 3, -1)
        y_a = short_conv_mixer(a_h, a_b, a_c, sc_conv_w[layer])
        z, xbc, dt_raw = jnp.split(pb, [SSM_D_INNER, SSM_D_INNER + SSM_CONV_DIM], -1)
        y_b = mamba2_mixer(z, xbc, dt_raw, ssm_conv_w[layer], ssm_conv_b[layer],
                           ssm_dt_bias[layer], ssm_a_log[layer], ssm_d[layer], ssm_norm_g[layer])
        y_c = gmlp_mixer(pc, gm_ln_g[layer], gm_ln_b[layer], gm_ws[layer], gm_bias[layer])
        y_d = pool_mixer(pd, pool_map[layer], pool_scale[layer])
        gates = jax.nn.sigmoid((h @ w_gate[layer]).astype(F32)).reshape(bsz, L, N_BRANCH, D)
        merged = (gates[:, :, 0] * (y_a @ w_br_a[layer]).astype(F32)
                  + gates[:, :, 1] * (y_b @ w_br_b[layer]).astype(F32)
                  + gates[:, :, 2] * (y_c @ w_br_c[layer]).astype(F32)
                  + gates[:, :, 3] * (y_d @ w_br_d[layer]).astype(F32))
        x = x + merged.astype(x.dtype) @ w_out[layer]
        h2 = rmsnorm(x, norm2_g[layer])
        idx = layer // 2
        if layer % 2 == 0:
            f = swiglu(h2, ffn_wg[idx], ffn_wu[idx], ffn_wd[idx])
        else:
            f = moe_ffn(h2, router_w[idx], moe_wg[idx], moe_wu[idx], moe_wd[idx])
        x = x + f
    return rmsnorm(x, final_g)
```

```cpp
#define MK_N_LAUNCHES 1
#include <hip/hip_runtime.h>
#include <cstdio>
#include <cstdint>

#ifndef MK_N_LAUNCHES
#define MK_N_LAUNCHES 1
#endif

#define LAS __attribute__((address_space(3)))
#define GAS __attribute__((address_space(1)))
typedef unsigned short bf16;
typedef short bf16x8 __attribute__((ext_vector_type(8)));
typedef float f32x4 __attribute__((ext_vector_type(4)));
typedef float f32x2 __attribute__((ext_vector_type(2)));
typedef unsigned u32x4 __attribute__((ext_vector_type(4)));
typedef unsigned u32x2 __attribute__((ext_vector_type(2)));
#define RLX_AGENT __ATOMIC_RELAXED, __HIP_MEMORY_SCOPE_AGENT
#define LDS_WAIT() asm volatile("s_waitcnt lgkmcnt(0)" ::: "memory")
#define VM_WAIT() asm volatile("s_waitcnt vmcnt(0)" ::: "memory")

constexpr int L = 16384, D = 1024, NWAVES = 8, NTHR = 512;
constexpr int PW = 6144;
constexpr int GW = 4096;
constexpr int YW = 2560;
constexpr int DFF = 2816, DFE = 3584, NE = 8;
constexpr int MAXSLOT = 34816;
constexpr float EPS = 1e-6f;

constexpr size_t MiB = 1u << 20;
constexpr size_t WS_CTL = 0, CTL_ZERO_BYTES = 1 * MiB;
constexpr size_t WS_SMALL = 1 * MiB;
constexpr size_t SM_GMW = 0, SM_POOLT = 256 * 1024, SM_WDT = 512 * 1024;
constexpr size_t WS_W1T = 2 * MiB;
constexpr size_t WS_BRT = 42 * MiB;
constexpr size_t WS_OUTT = 52 * MiB;
constexpr size_t WS_UPT = 56 * MiB;
constexpr size_t WS_DNT = 67 * MiB;
constexpr size_t WS_MOEDN = 2 * MiB;
constexpr size_t WS_XC = 74 * MiB;
constexpr size_t WS_R = 138 * MiB;
constexpr size_t WS_H = WS_R;
constexpr size_t WS_PROJ = WS_R + 32 * MiB;
constexpr size_t WS_YCAT = WS_R + 224 * MiB;
constexpr size_t WS_STATES = WS_R + 304 * MiB;
constexpr size_t WS_DACS = WS_R + 368 * MiB;
constexpr size_t WS_CC = WS_R + 369 * MiB;
constexpr size_t WS_GATES = WS_R + 32 * MiB;
constexpr size_t WS_MERGED = WS_R + 160 * MiB;
constexpr size_t WS_H2 = WS_R;
constexpr size_t WS_ACT = WS_R + 32 * MiB;
constexpr size_t WS_MOEUP = WS_R + 32 * MiB;
constexpr size_t WS_ROUTE = WS_R + 144 * MiB;
constexpr size_t RT_TOPK = 0, RT_CNT = 256 * 1024, RT_ROWIDX = 288 * 1024, RT_TOKSLOT = 448 * 1024, RT_TILEE = 640 * 1024, RT_NT = 644 * 1024;
constexpr size_t WS_ACTM = WS_R + 164 * MiB;
constexpr size_t WS_YBUF = WS_R + 32 * MiB;
constexpr size_t WS_END = 540 * MiB;
static_assert(WS_ACTM + (size_t)MAXSLOT * DFE * 2 <= WS_END, "ws map");
static_assert(WS_CC + (size_t)L * 512 * 2 <= WS_END, "ws map");
constexpr int CW_TMO = 0, CW_BAR = 4096;

constexpr int LDS_BYTES = 147456;
constexpr int MISC_OFF = LDS_BYTES - 256;
constexpr int WORK_BYTES = MISC_OFF;

typedef __bf16 bf16x2_t __attribute__((ext_vector_type(2)));
__device__ __forceinline__ unsigned cvt_pk_bf16(float lo, float hi) { const f32x2 v = {lo, hi}; const bf16x2_t r = __builtin_convertvector(v, bf16x2_t); return __builtin_bit_cast(unsigned, r); }
__device__ __forceinline__ float bflo(unsigned u) { return __uint_as_float(u << 16); }
__device__ __forceinline__ float bfhi(unsigned u) { return __uint_as_float(u & 0xffff0000u); }
__device__ __forceinline__ float bf1(bf16 b) { return __uint_as_float(((unsigned)b) << 16); }
__device__ __forceinline__ bf16 f2bf(float f) { return (bf16)(cvt_pk_bf16(f, 0.f) & 0xffffu); }
__device__ __forceinline__ void unpack8(const u32x4 v, float (&o)[8]) { o[0] = bflo(v.x); o[1] = bfhi(v.x); o[2] = bflo(v.y); o[3] = bfhi(v.y); o[4] = bflo(v.z); o[5] = bfhi(v.z); o[6] = bflo(v.w); o[7] = bfhi(v.w); }
__device__ __forceinline__ u32x4 pack8(const float (&o)[8]) { u32x4 v; v.x = cvt_pk_bf16(o[0], o[1]); v.y = cvt_pk_bf16(o[2], o[3]); v.z = cvt_pk_bf16(o[4], o[5]); v.w = cvt_pk_bf16(o[6], o[7]); return v; }
__device__ __forceinline__ float fast_exp(float x) { return __builtin_amdgcn_exp2f(x * 1.4426950408889634f); }
__device__ __forceinline__ float fast_rcp(float x) { return __builtin_amdgcn_rcpf(x); }
__device__ __forceinline__ float sigmoid_f(float x) { return fast_rcp(1.f + fast_exp(-x)); }
__device__ __forceinline__ float silu_f(float x) { return x * sigmoid_f(x); }
__device__ __forceinline__ float gelu_tanh_f(float x) { const float u = 0.7978845608028654f * (x + 0.044715f * x * x * x); return x * sigmoid_f(2.f * u); }
__device__ __forceinline__ float softplus_f(float x) { return fmaxf(x, 0.f) + log1pf(expf(-fabsf(x))); }
__device__ __forceinline__ float wave_sum(float v) {
#pragma unroll
    for (int o = 1; o < 64; o <<= 1) v += __shfl_xor(v, o);
    return v;
}
#define MMA16(acc, q, p) (acc) = __builtin_amdgcn_mfma_f32_16x16x32_bf16((q), (p), (acc), 0, 0, 0)
__device__ __forceinline__ bf16x8 ldsfrag(LAS unsigned char* base, int byteoff) { return *(const LAS bf16x8*)(base + byteoff); }
__device__ __forceinline__ bf16x8 gfrag(const bf16* p) { return *(const bf16x8*)p; }

#define XB_TMO      128
#define XB_XCNT(j)  (256  + 64 * (j))
#define XB_XSUB(j)  (1280 + 64 * (j))
#define XB_XGEN(j)  (2304 + 64 * (j))
#define XB_TOP      3328
#define XB_TOPGEN   3392
#define XCD_BAR_WORDS 3456
#define XB_SPIN_CAP (1u << 18)
__device__ __forceinline__ unsigned xb_ld(unsigned* p)              { return __hip_atomic_load(p, __ATOMIC_RELAXED, __HIP_MEMORY_SCOPE_AGENT); }
__device__ __forceinline__ unsigned xb_add(unsigned* p, unsigned v) { return __hip_atomic_fetch_add(p, v, __ATOMIC_RELAXED, __HIP_MEMORY_SCOPE_AGENT); }
__device__ __forceinline__ unsigned xb_xcc_id() { return (unsigned)__builtin_amdgcn_s_getreg((3 << 11) | 20) & 0xFu; }
#define XB_SPIN(cond, bar) do { unsigned _sp = 0; while (cond) { __builtin_amdgcn_s_sleep(1); \
    if ((++_sp & 255u) == 0u) { if (xb_ld(&(bar)[XB_TMO])) break; if (_sp > XB_SPIN_CAP) { atomicAdd(&(bar)[XB_TMO], 1u); break; } } } } while (0)
struct XcdBarrier { unsigned* bar; unsigned x; volatile LAS unsigned* st; };
__device__ __forceinline__ XcdBarrier xcd_barrier_post(unsigned* bar, volatile LAS unsigned* st) {
    XcdBarrier b; b.bar = bar; b.x = xb_xcc_id(); b.st = st;
    if (threadIdx.x == 0) (void)xb_add(&bar[XB_XCNT(b.x)], 1u);
    return b;
}
__device__ __forceinline__ void xcd_barrier_complete(unsigned* bar, unsigned x, unsigned& nloc, unsigned& nx) {
    const unsigned G = gridDim.x * gridDim.y * gridDim.z;
    unsigned sum, cnt, mine, sp = 0u;
    for (;;) {
        sum = 0u; cnt = 0u; mine = 0u;
#pragma unroll
        for (unsigned j = 0; j < 16; ++j) { const unsigned c = xb_ld(&bar[XB_XCNT(j)]); sum += c; cnt += (c > 0u) ? 1u : 0u; mine = (j == x) ? c : mine; }
        if (sum == G) break;
        __builtin_amdgcn_s_sleep(1);
        if ((++sp & 255u) == 0u) { if (xb_ld(&bar[XB_TMO])) break; if (sp > XB_SPIN_CAP) { atomicAdd(&bar[XB_TMO], 1u); break; } }
    }
    nloc = mine > 0u ? mine : 1u; nx = cnt > 0u ? cnt : 1u;
}
__device__ __forceinline__ void xcd_barrier(const XcdBarrier& b) {
    asm volatile("s_waitcnt vmcnt(0)" ::: "memory");
    __syncthreads();
    if (threadIdx.x == 0) {
        unsigned* bar = b.bar;
        __builtin_amdgcn_s_waitcnt(0);
        unsigned nloc = b.st[0], nx = b.st[1];
        if (nloc == 0u) { xcd_barrier_complete(bar, b.x, nloc, nx); b.st[0] = nloc; b.st[1] = nx; }
        const unsigned old = xb_add(&bar[XB_XSUB(b.x)], 1u);
        const unsigned gen = old / nloc;
        if (old + 1u == (gen + 1u) * nloc) {
            __builtin_amdgcn_fence(__ATOMIC_RELEASE, "agent");
            asm volatile("s_waitcnt vmcnt(0)" ::: "memory");
            const unsigned og = xb_add(&bar[XB_TOP], 1u);
            const unsigned tg = og / nx;
            if (og + 1u == (tg + 1u) * nx) xb_add(&bar[XB_TOPGEN], 1u);
            else XB_SPIN(xb_ld(&bar[XB_TOPGEN]) == tg, bar);
            __builtin_amdgcn_fence(__ATOMIC_ACQUIRE, "agent");
            xb_add(&bar[XB_XGEN(b.x)], 1u);
            asm volatile("s_waitcnt vmcnt(0)" ::: "memory");
        } else {
            XB_SPIN(xb_ld(&bar[XB_XGEN(b.x)]) == gen, bar);
            __builtin_amdgcn_fence(__ATOMIC_ACQUIRE, "agent");
            asm volatile("s_waitcnt vmcnt(0)" ::: "memory");
        }
    }
    __syncthreads();
}
namespace pg8 {
constexpr int BM = 256, BK = 64, HALF = 128, HTB = HALF * BK * 2, STAGE_BYTES = 8 * HTB, NXCD = 8, WGM = 8;
__host__ __device__ __forceinline__ int lds_byte(int r, int c) { const int st = (r >> 4) * 2 + (c >> 5), rr = r & 15, cc = c & 31, ob = rr * 64 + cc * 2; return st * 1024 + (ob ^ (((ob >> 9) & 1) << 5)); }
__host__ __device__ __forceinline__ void stage_rc(int b, int& R, int& C) { const int st = b / 1024, sb = b % 1024, swz = sb ^ (((sb >> 9) & 1) << 5); R = (st >> 1) * 16 + swz / 64; C = (st & 1) * 32 + (swz % 64) / 2; }
__host__ __device__ __forceinline__ int perm32(int rho) { const int n = rho >> 4, i = rho & 15; return 8 * (i >> 2) + 4 * n + (i & 3); }

struct Unit { int pm, pn; const char* a; const char* b; };
struct TileOrder {
    int nM, nN, nwg, G, c;
    __device__ __forceinline__ void init(int nM_, int nN_, int G_, int c_) { nM = nM_; nN = nN_; nwg = nM * nN; G = G_; c = c_; }
    __device__ __forceinline__ bool tile(int i, int& pm, int& pn) const {
        const long Lq = (long)i * G + c; if (Lq >= nwg) return false;
        int wgid = (int)Lq; { const int q = nwg / NXCD, r = nwg % NXCD, xcd = wgid % NXCD, off = wgid / NXCD; wgid = (xcd < r ? xcd * (q + 1) : r * (q + 1) + (xcd - r) * q) + off; }
        const int nig = WGM * nN, gid = wgid / nig, fm = gid * WGM, gsz = (nM - fm) < WGM ? (nM - fm) : WGM;
        pm = fm + ((wgid % nig) % gsz); pn = (wgid % nig) / gsz; return true;
    }
};
struct DenseSched {
    TileOrder o; const char* A; const char* Bt; size_t tstep;
    __device__ __forceinline__ void init(const bf16* A_, const bf16* Bt_, int M, int N, int K, int G, int c) { o.init(M / BM, N / BM, G, c); A = (const char*)A_; Bt = (const char*)Bt_; tstep = (size_t)BM * K * 2; }
    __device__ __forceinline__ bool next(int i, Unit& u) const { if (!o.tile(i, u.pm, u.pn)) return false; u.a = A + (size_t)u.pm * tstep; u.b = Bt + (size_t)u.pn * tstep; return true; }
    __device__ __forceinline__ unsigned arow(const Unit&, int) const { return 0u; }
};

__device__ __forceinline__ unsigned cvt_pk(float lo, float hi) { return cvt_pk_bf16(lo, hi); }

struct EpiBf16Act {
    static constexpr bool PERM = true, HAS_MID = false;
    bf16* O; int ldc; int gelu_lo, gelu_hi; int sig;
    __device__ __forceinline__ void operator()(f32x4 (&acc)[2][2][4][2], const Unit& u, int wr, int wc, int fr, int fq) const {
        asm volatile("" : "+v"(fr), "+v"(fq));
        const int row0 = u.pm * BM + wr * 64 + fr, col0 = u.pn * BM + wc * 32 + 8 * fq;
        const int mode = sig ? 2 : ((u.pn >= gelu_lo && u.pn < gelu_hi) ? 1 : 0);
#pragma unroll
        for (int ai = 0; ai < 2; ++ai)
#pragma unroll
            for (int m = 0; m < 4; ++m) { bf16* rowp = O + (size_t)(row0 + ai * HALF + m * 16) * ldc + col0;
#pragma unroll
                for (int bj = 0; bj < 2; ++bj) { f32x4 v0 = acc[ai][bj][m][0], v1 = acc[ai][bj][m][1];
                    if (mode == 1) {
#pragma unroll
                        for (int j = 0; j < 4; ++j) { v0[j] = gelu_tanh_f(v0[j]); v1[j] = gelu_tanh_f(v1[j]); } }
                    else if (mode == 2) {
#pragma unroll
                        for (int j = 0; j < 4; ++j) { v0[j] = sigmoid_f(v0[j]); v1[j] = sigmoid_f(v1[j]); } }
                    u32x4 w; w.x = cvt_pk(v0[0], v0[1]); w.y = cvt_pk(v0[2], v0[3]); w.z = cvt_pk(v1[0], v1[1]); w.w = cvt_pk(v1[2], v1[3]);
                    *(u32x4*)(rowp + bj * HALF) = w; } }
    }
};
struct EpiSwiglu {
    static constexpr bool PERM = true, HAS_MID = false;
    bf16* O; int ldc;
    __device__ __forceinline__ void operator()(f32x4 (&acc)[2][2][4][2], const Unit& u, int wr, int wc, int fr, int fq) const {
        asm volatile("" : "+v"(fr), "+v"(fq));
        const int row0 = u.pm * BM + wr * 64 + fr, col0 = u.pn * HALF + wc * 32 + 8 * fq;
#pragma unroll
        for (int ai = 0; ai < 2; ++ai)
#pragma unroll
            for (int m = 0; m < 4; ++m) { bf16* rowp = O + (size_t)(row0 + ai * HALF + m * 16) * ldc + col0;
                f32x4 v0, v1;
#pragma unroll
                for (int j = 0; j < 4; ++j) { v0[j] = silu_f(acc[ai][0][m][0][j]) * acc[ai][1][m][0][j]; v1[j] = silu_f(acc[ai][0][m][1][j]) * acc[ai][1][m][1][j]; }
                u32x4 w; w.x = cvt_pk(v0[0], v0[1]); w.y = cvt_pk(v0[2], v0[3]); w.z = cvt_pk(v1[0], v1[1]); w.w = cvt_pk(v1[2], v1[3]);
                *(u32x4*)rowp = w; }
    }
};
struct EpiResid {
    static constexpr bool PERM = false, HAS_MID = false;
    const float* R; float* O; int ldc;
    __device__ __forceinline__ void operator()(f32x4 (&acc)[2][2][4][2], const Unit& u, int wr, int wc, int fr, int fq) const {
        asm volatile("" : "+v"(fr), "+v"(fq));
        const int row0 = u.pm * BM + wr * 64 + fr, col0 = u.pn * BM + wc * 32 + 4 * fq;
#pragma unroll
        for (int ai = 0; ai < 2; ++ai)
#pragma unroll
            for (int m = 0; m < 4; ++m) { const size_t off = (size_t)(row0 + ai * HALF + m * 16) * ldc + col0;
#pragma unroll
                for (int bj = 0; bj < 2; ++bj)
#pragma unroll
                    for (int n = 0; n < 2; ++n) { const f32x4 r = *(const f32x4*)(R + off + bj * HALF + n * 16); *(f32x4*)(O + off + bj * HALF + n * 16) = r + acc[ai][bj][m][n]; }
                asm volatile("" ::: "memory"); }
    }
};
struct EpiMerge {
    static constexpr bool PERM = true, HAS_MID = true;
    const bf16* Gt; bf16* O;
    __device__ __forceinline__ int mid_branch(int kdone) const { return kdone == 512 ? 1 : (kdone == 1536 ? 2 : (kdone == 2048 ? 3 : 0)); }
    __device__ __forceinline__ void mid(f32x4 (&acc)[2][2][4][2], const Unit& u, int nb, int wr, int wc, int fr, int fq) const {
        asm volatile("" : "+v"(fr), "+v"(fq));
        const int row0 = u.pm * BM + wr * 64 + fr, col0 = u.pn * BM + wc * 32 + 8 * fq;
#pragma unroll
        for (int ai = 0; ai < 2; ++ai)
#pragma unroll
            for (int m = 0; m < 4; ++m) { const unsigned go = (unsigned)(row0 + ai * HALF + m * 16) * (unsigned)GW + (unsigned)col0 + (unsigned)(nb - 1) * 1024u;
#pragma unroll
                for (int bj = 0; bj < 2; ++bj) { const u32x4 a = *(const u32x4*)(Gt + (go + bj * HALF)), b = *(const u32x4*)(Gt + (go + 1024u + bj * HALF));
                    float ga[8], gb[8]; unpack8(a, ga); unpack8(b, gb);
#pragma unroll
                    for (int j = 0; j < 4; ++j) { acc[ai][bj][m][0][j] *= ga[j] * fast_rcp(gb[j]); acc[ai][bj][m][1][j] *= ga[4 + j] * fast_rcp(gb[4 + j]); }
                    asm volatile("" : "+v"(acc[ai][bj][m][0]), "+v"(acc[ai][bj][m][1]) :: "memory"); } }
    }
    __device__ __forceinline__ void operator()(f32x4 (&acc)[2][2][4][2], const Unit& u, int wr, int wc, int fr, int fq) const {
        asm volatile("" : "+v"(fr), "+v"(fq));
        const int row0 = u.pm * BM + wr * 64 + fr, col0 = u.pn * BM + wc * 32 + 8 * fq;
#pragma unroll
        for (int ai = 0; ai < 2; ++ai)
#pragma unroll
            for (int m = 0; m < 4; ++m) { const unsigned r = (unsigned)(row0 + ai * HALF + m * 16);
#pragma unroll
                for (int bj = 0; bj < 2; ++bj) { const u32x4 g3 = *(const u32x4*)(Gt + (r * (unsigned)GW + 3072u + (unsigned)col0 + bj * HALF)); float g[8]; unpack8(g3, g);
                    const f32x4 v0 = acc[ai][bj][m][0], v1 = acc[ai][bj][m][1];
                    u32x4 w; w.x = cvt_pk(v0[0] * g[0], v0[1] * g[1]); w.y = cvt_pk(v0[2] * g[2], v0[3] * g[3]); w.z = cvt_pk(v1[0] * g[4], v1[1] * g[5]); w.w = cvt_pk(v1[2] * g[6], v1[3] * g[7]);
                    *(u32x4*)(O + (r * (unsigned)D + (unsigned)col0 + bj * HALF)) = w; }
                asm volatile("" ::: "memory"); }
    }
};

template <class Epi, class Sched, bool ALIGN_EPI, bool GATHER>
__device__ __forceinline__ void gemm_phase(LAS unsigned char* lds, const int K, const Sched& S, const Epi& E) {
    int tid_ = threadIdx.x; asm volatile("" : "+v"(tid_)); const int tid = tid_, wid = __builtin_amdgcn_readfirstlane(tid >> 6), lane = tid & 63, wr = wid >> 2, wc = wid & 3, fr = lane & 15, fq = lane >> 4;
    const int nt = K / BK;
    unsigned voffB[2], aoC[2][2], aoN[2][2];
#pragma unroll
    for (int i = 0; i < 2; ++i) { int R, C; stage_rc(tid * 16 + i * 8192, R, C); const int Rb = Epi::PERM ? ((R & ~31) + perm32(R & 31)) : R;
        voffB[i] = (unsigned)(Rb * K + C) * 2u;
#pragma unroll
        for (int h = 0; h < 2; ++h) { aoC[h][i] = (unsigned)((R + h * HALF) * K + C) * 2u; aoN[h][i] = aoC[h][i]; } }
    const size_t kstep = (size_t)(BK * 2);
    const size_t hstep = (size_t)HALF * K * 2;
    const size_t pstep = (size_t)64 * K * 2;
    const unsigned ldsw = (unsigned)wid * 1024u;
    const int aoff = lds_byte(wr * 64 + fr, fq * 8), boff = lds_byte(wc * 32 + fr, fq * 8);
#define PG8_SA(b, h) (((b) * 2 + (h)) * HTB)
#define PG8_SB(b, h) ((4 + (b) * 2 + (h)) * HTB)
#define PG8_STAGE(bufoff, gbase, voff) do { _Pragma("unroll") for (int _i = 0; _i < 2; ++_i) \
        __builtin_amdgcn_global_load_lds((const unsigned*)((const char*)(gbase) + (voff)[_i]), (LAS unsigned*)(lds + (bufoff) + ldsw + _i * 8192), 16, 0, 0); } while (0)
#define PG8_STAGE1(bufoff, gbase, voff0) do { _Pragma("unroll") for (int _i = 0; _i < 2; ++_i) \
        __builtin_amdgcn_global_load_lds((const unsigned*)((const char*)(gbase) + (size_t)_i * pstep + (voff0)), (LAS unsigned*)(lds + (bufoff) + ldsw + _i * 8192), 16, 0, 0); } while (0)
#define PG8_STAGE_A2(bufoff, gbase, h) do { if (GATHER && last) PG8_STAGE(bufoff, gbase, aoN[h]); else PG8_STAGE(bufoff, gbase, aoC[h]); } while (0)
#define PG8_LDA(dst, b, h) do { _Pragma("unroll") for (int m = 0; m < 4; ++m) _Pragma("unroll") for (int k = 0; k < 2; ++k) dst[m][k] = *(const LAS bf16x8*)(lds + PG8_SA(b, h) + aoff + m * 2048 + k * 1024); } while (0)
#define PG8_LDB(dst, b, h) do { _Pragma("unroll") for (int n = 0; n < 2; ++n) _Pragma("unroll") for (int k = 0; k < 2; ++k) dst[n][k] = *(const LAS bf16x8*)(lds + PG8_SB(b, h) + boff + n * 2048 + k * 1024); } while (0)
#define PG8_MMA(ai, bj, At, Bt) do { __builtin_amdgcn_s_setprio(1); _Pragma("unroll") for (int m = 0; m < 4; ++m) _Pragma("unroll") for (int n = 0; n < 2; ++n) _Pragma("unroll") for (int k = 0; k < 2; ++k) \
        acc[ai][bj][m][n] = __builtin_amdgcn_mfma_f32_16x16x32_bf16(Bt[n][k], At[m][k], acc[ai][bj][m][n], 0, 0, 0); __builtin_amdgcn_s_setprio(0); } while (0)
#define PG8_WAIT_V(n) asm volatile("s_waitcnt vmcnt(" #n ")" ::: "memory")
#define PG8_WAIT_L(n) asm volatile("s_waitcnt lgkmcnt(" #n ")" ::: "memory")
#define PG8_BAR __builtin_amdgcn_s_barrier()
#define PG8_SCHED __builtin_amdgcn_sched_barrier(0)
    Unit cur, nxt; int ui = 0;
    if (!S.next(0, cur)) return;
    if constexpr (GATHER) {
#pragma unroll
        for (int h = 0; h < 2; ++h)
#pragma unroll
            for (int i = 0; i < 2; ++i) { int R, C; stage_rc(tid * 16 + i * 8192, R, C); aoC[h][i] = (S.arow(cur, h * HALF + R) * (unsigned)K + (unsigned)C) * 2u; }
    }
    f32x4 acc[2][2][4][2];
#pragma unroll
    for (int a = 0; a < 2; ++a)
#pragma unroll
        for (int b = 0; b < 2; ++b)
#pragma unroll
            for (int m = 0; m < 4; ++m)
#pragma unroll
                for (int n = 0; n < 2; ++n) acc[a][b][m][n] = (f32x4){0.f, 0.f, 0.f, 0.f};
    bf16x8 At[4][2], B0[2][2], B1[2][2];
    const char* cA = cur.a; const char* cB = cur.b;
    PG8_STAGE1(PG8_SB(0, 0), cB, voffB[0]); PG8_STAGE1(PG8_SB(0, 1), cB + hstep, voffB[0]); PG8_STAGE(PG8_SA(0, 0), cA, aoC[0]); PG8_STAGE(PG8_SA(0, 1), cA, aoC[1]);
    if (wr == 1) PG8_BAR;
    PG8_WAIT_V(2); PG8_BAR;
    PG8_STAGE1(PG8_SB(1, 0), cB + kstep, voffB[0]); PG8_STAGE(PG8_SA(1, 0), cA + kstep, aoC[0]); PG8_STAGE1(PG8_SB(1, 1), cB + hstep + kstep, voffB[0]);
    PG8_WAIT_V(6); PG8_BAR;
    for (;;) {
        const bool has_next = S.next(ui + 1, nxt);
        const char* nA = has_next ? nxt.a : cA; const char* nB = has_next ? nxt.b : cB;
        if constexpr (GATHER) {
#pragma unroll
            for (int h = 0; h < 2; ++h)
#pragma unroll
                for (int i = 0; i < 2; ++i) { int R, C; stage_rc(tid * 16 + i * 8192, R, C); aoN[h][i] = has_next ? (S.arow(nxt, h * HALF + R) * (unsigned)K + (unsigned)C) * 2u : aoC[h][i]; }
        }
        for (int t = 0; t < nt; t += 2) {
            const bool last = (t == nt - 2);
            const char* a1 = cA + (size_t)(t + 1) * kstep;
            const char* a2 = last ? nA : cA + (size_t)(t + 2) * kstep; const char* b2 = last ? nB : cB + (size_t)(t + 2) * kstep;
            const char* a3 = a2 + kstep; const char* b3 = b2 + kstep;
            PG8_LDB(B0, 0, 0); PG8_LDB(B1, 0, 1); PG8_SCHED; PG8_LDA(At, 0, 0); PG8_STAGE(PG8_SA(1, 1), a1, aoC[1]);
            PG8_WAIT_V(8); PG8_WAIT_L(0); PG8_BAR; PG8_MMA(0, 0, At, B0); PG8_MMA(0, 1, At, B1); PG8_BAR; PG8_SCHED;
            PG8_LDA(At, 0, 1); PG8_STAGE1(PG8_SB(0, 0), b2, voffB[0]); PG8_STAGE1(PG8_SB(0, 1), b2 + hstep, voffB[0]); PG8_STAGE_A2(PG8_SA(0, 0), a2, 0);
            PG8_WAIT_V(8); PG8_WAIT_L(0); PG8_BAR; PG8_MMA(1, 0, At, B0); PG8_MMA(1, 1, At, B1); PG8_BAR; PG8_SCHED;
            PG8_LDB(B0, 1, 0); PG8_LDB(B1, 1, 1); PG8_SCHED; PG8_LDA(At, 1, 0); PG8_STAGE_A2(PG8_SA(0, 1), a2, 1);
            PG8_WAIT_V(8); PG8_WAIT_L(0); PG8_BAR; PG8_MMA(0, 0, At, B0); PG8_MMA(0, 1, At, B1); PG8_BAR; PG8_SCHED;
            PG8_LDA(At, 1, 1); PG8_STAGE1(PG8_SB(1, 0), b3, voffB[0]); PG8_STAGE1(PG8_SB(1, 1), b3 + hstep, voffB[0]); PG8_STAGE_A2(PG8_SA(1, 0), a3, 0);
            PG8_WAIT_V(8); PG8_WAIT_L(0); PG8_BAR; PG8_MMA(1, 0, At, B0); PG8_MMA(1, 1, At, B1); PG8_BAR; PG8_SCHED;
            if constexpr (Epi::HAS_MID) { const int nb = E.mid_branch((t + 2) * BK); if (nb) { PG8_SCHED; E.mid(acc, cur, nb, wr, wc, fr, fq); PG8_SCHED; } }
        }
        if constexpr (ALIGN_EPI) { if (wr == 0) PG8_BAR; }
        E(acc, cur, wr, wc, fr, fq);
        if (!has_next) break;
#pragma unroll
        for (int a = 0; a < 2; ++a)
#pragma unroll
            for (int b = 0; b < 2; ++b)
#pragma unroll
                for (int m = 0; m < 4; ++m)
#pragma unroll
                    for (int n = 0; n < 2; ++n) acc[a][b][m][n] = (f32x4){0.f, 0.f, 0.f, 0.f};
        cur = nxt; cA = nA; cB = nB; ++ui;
        if constexpr (GATHER) {
#pragma unroll
            for (int h = 0; h < 2; ++h)
#pragma unroll
                for (int i = 0; i < 2; ++i) aoC[h][i] = aoN[h][i];
        }
        if constexpr (ALIGN_EPI) { if (wr == 1) PG8_BAR; }
    }
    PG8_WAIT_V(0);
    if constexpr (!ALIGN_EPI) { if (wr == 0) PG8_BAR; }
    PG8_BAR;
#undef PG8_SA
#undef PG8_SB
#undef PG8_STAGE
#undef PG8_STAGE1
#undef PG8_STAGE_A2
#undef PG8_LDA
#undef PG8_LDB
#undef PG8_MMA
#undef PG8_WAIT_V
#undef PG8_WAIT_L
#undef PG8_BAR
#undef PG8_SCHED
}
}
struct Frame {
    LAS unsigned char* lds;
    volatile LAS unsigned* MISC;
    unsigned* ctl;
    unsigned char* ws;
    const float* const* in;
    float* out;
    int tid, lane, wave, G, bid;
};
#define WSP(T, off) ((T*)(F.ws + (off)))

__device__ __forceinline__ void tr_item(const float* src, int ldsrc, bf16* dst, int ldd, LAS float* scr, int lane) {
#pragma unroll 8
    for (int i = 0; i < 32; ++i) { const int kk = 2 * i + (lane >> 5); scr[kk * 33 + (lane & 31)] = src[(size_t)kk * ldsrc + (lane & 31)]; }
    LDS_WAIT(); asm volatile("" ::: "memory");
    const int c = lane & 7;
#pragma unroll
    for (int j = 0; j < 4; ++j) { const int n = (lane >> 3) + 8 * j; const LAS float* s = scr + (8 * c) * 33 + n;
        u32x4 o; o.x = cvt_pk_bf16(s[0 * 33], s[1 * 33]); o.y = cvt_pk_bf16(s[2 * 33], s[3 * 33]); o.z = cvt_pk_bf16(s[4 * 33], s[5 * 33]); o.w = cvt_pk_bf16(s[6 * 33], s[7 * 33]);
        *(u32x4*)(dst + (size_t)n * ldd + 8 * c) = o; }
    LDS_WAIT(); asm volatile("" ::: "memory");
}
__device__ __forceinline__ void tr_job_item(const float* src, int ldsrc, int sc0, int K, int N, bf16* dst, int ldd, int dr0, int dk0, int it, LAS float* scr, int lane) {
    const int nblk = N / 32, kb = it / nblk, nb = it % nblk;
    tr_item(src + (size_t)(64 * kb) * ldsrc + sc0 + 32 * nb, ldsrc, dst + (size_t)(dr0 + 32 * nb) * ldd + dk0 + 64 * kb, ldd, scr, lane);
}
__device__ __forceinline__ void tr_up_item(const float* wg, const float* wu, int FF, bf16* dst, int it, LAS float* scr, int lane) {
    const int nblk = 2 * FF / 32, kb = it / nblk, nb = it % nblk, r0 = 32 * nb, pn = r0 >> 8, s = (r0 >> 7) & 1, j = r0 & 127;
    const float* src = (s ? wu : wg) + (size_t)(64 * kb) * FF + 128 * pn + j;
    tr_item(src, FF, dst + (size_t)r0 * D + 64 * kb, D, scr, lane);
}
__device__ __forceinline__ void convert_layer_weights(Frame& F, int l, int gw, int NGW) {
    LAS float* scr = (LAS float*)(F.lds + F.wave * 8448);
    const float* w_in = F.in[2] + (size_t)l * D * 6160; const float* w_gate = F.in[3] + (size_t)l * D * 4096;
    bf16* W1T = WSP(bf16, WS_W1T) + (size_t)l * 10240 * D; bf16* BRT = WSP(bf16, WS_BRT) + (size_t)l * D * YW; bf16* OUTT = WSP(bf16, WS_OUTT) + (size_t)l * D * D;
    constexpr int I_A = 16 * (4608 / 32), I_B = 16 * (1536 / 32), I_G = 16 * (4096 / 32);
    constexpr int I_BA = 8 * 32, I_BB = 16 * 32, I_BC = 8 * 32, I_BD = 8 * 32, I_O = 16 * 32;
    constexpr int NIT = I_A + I_B + I_G + I_BA + I_BB + I_BC + I_BD + I_O;
    for (int it = gw; it < NIT; it += NGW) {
        int r = it;
        if (r < I_A) { tr_job_item(w_in, 6160, 0, D, 4608, W1T, D, 0, 0, r, scr, F.lane); continue; } r -= I_A;
        if (r < I_B) { tr_job_item(w_in, 6160, 4624, D, 1536, W1T, D, 4608, 0, r, scr, F.lane); continue; } r -= I_B;
        if (r < I_G) { tr_job_item(w_gate, 4096, 0, D, 4096, W1T, D, 6144, 0, r, scr, F.lane); continue; } r -= I_G;
        if (r < I_BA) { tr_job_item(F.in[17] + (size_t)l * 512 * D, D, 0, 512, D, BRT, YW, 0, 0, r, scr, F.lane); continue; } r -= I_BA;
        if (r < I_BB) { tr_job_item(F.in[18] + (size_t)l * 1024 * D, D, 0, 1024, D, BRT, YW, 0, 512, r, scr, F.lane); continue; } r -= I_BB;
        if (r < I_BC) { tr_job_item(F.in[19] + (size_t)l * 512 * D, D, 0, 512, D, BRT, YW, 0, 1536, r, scr, F.lane); continue; } r -= I_BC;
        if (r < I_BD) { tr_job_item(F.in[20] + (size_t)l * 512 * D, D, 0, 512, D, BRT, YW, 0, 2048, r, scr, F.lane); continue; } r -= I_BD;
        tr_job_item(F.in[21] + (size_t)l * D * D, D, 0, D, D, OUTT, D, 0, 0, r, scr, F.lane);
    }
    for (int it = gw; it < 4 * 8; it += NGW) { const int g = it >> 3, r = it & 7;
        tr_job_item(F.in[15] + ((size_t)l * 4 + g) * 128 * 128, 128, 0, 128, 128, WSP(bf16, WS_SMALL + SM_POOLT) + ((size_t)l * 4 + g) * 128 * 128, 128, 0, 0, r, scr, F.lane); }
    const int gt = gw * 64 + F.lane, NGT = NGW * 64;
    for (int i = gt; i < 4 * 128 * 128; i += NGT) { const int s = i & 127, t = (i >> 7) & 127; const float v = F.in[13][(size_t)l * 65536 + i];
        WSP(bf16, WS_SMALL + SM_GMW)[(size_t)l * 65536 + i] = f2bf(s <= t ? v : 0.f); }
    for (int i = gt; i < 16 * 1024; i += NGT) { const int k = i >> 4, j = i & 15; WSP(bf16, WS_SMALL + SM_WDT)[(size_t)l * 16384 + j * 1024 + k] = f2bf(w_in[(size_t)k * 6160 + 4608 + j]); }
}
__device__ __forceinline__ void convert_ffn_weights(Frame& F, int gw, int NGW) {
    LAS float* scr = (LAS float*)(F.lds + F.wave * 8448);
    constexpr int I_U = 16 * (2 * DFF / 32), I_D = (DFF / 64) * (D / 32);
    for (int it = gw; it < I_U + I_D; it += NGW) {
        if (it < I_U) tr_up_item(F.in[23], F.in[24], DFF, WSP(bf16, WS_UPT), it, scr, F.lane);
        else tr_job_item(F.in[25], D, 0, DFF, D, WSP(bf16, WS_DNT), DFF, 0, 0, it - I_U, scr, F.lane);
    }
}
__device__ __forceinline__ void convert_moe_weights(Frame& F, int gw, int NGW) {
    LAS float* scr = (LAS float*)(F.lds + F.wave * 8448);
    constexpr int I_U = 16 * (2 * DFE / 32), I_D = (DFE / 64) * (D / 32);
    for (int it = gw; it < NE * (I_U + I_D); it += NGW) {
        const int e = it / (I_U + I_D), r = it % (I_U + I_D);
        if (r < I_U) tr_up_item(F.in[27] + (size_t)e * D * DFE, F.in[28] + (size_t)e * D * DFE, DFE, WSP(bf16, WS_MOEUP) + (size_t)e * 2 * DFE * D, r, scr, F.lane);
        else tr_job_item(F.in[29] + (size_t)e * DFE * D, D, 0, DFE, D, WSP(bf16, WS_MOEDN) + (size_t)e * D * DFE, DFE, 0, 0, r - I_U, scr, F.lane);
    }
}

__device__ __forceinline__ void rms_row(const float* xrow, const float* g, bf16* orow, int lane, f32x4 (&v)[4]) {
    const f32x4* xr = (const f32x4*)xrow + lane;
    float s = 0.f;
#pragma unroll
    for (int j = 0; j < 4; ++j) { v[j] = xr[64 * j]; s += (v[j].x * v[j].x + v[j].y * v[j].y) + (v[j].z * v[j].z + v[j].w * v[j].w); }
    const float r = 1.0f / sqrtf(wave_sum(s) * (1.f / D) + EPS);
    u32x2* o8 = (u32x2*)orow + lane;
#pragma unroll
    for (int j = 0; j < 4; ++j) { const f32x4 gv = ((const f32x4*)g)[64 * j + lane]; v[j] = v[j] * r * gv; u32x2 w; w.x = cvt_pk_bf16(v[j].x, v[j].y); w.y = cvt_pk_bf16(v[j].z, v[j].w); o8[64 * j] = w; }
}
__device__ __forceinline__ void rmsnorm_phase(Frame& F, const float* x, const float* g, bf16* out) {
    const int gw = F.bid * NWAVES + F.wave, NGW = F.G * NWAVES;
    for (int m = gw; m < L; m += NGW) { f32x4 v[4]; rms_row(x + (size_t)m * D, g, out + (size_t)m * D, F.lane, v); }
}

__device__ __forceinline__ void route_phase(Frame& F, const float* x, const float* g, bf16* out, const float* rw) {
    LAS float* RW = (LAS float*)F.lds;
    LAS int* HC = (LAS int*)(F.lds + 32768);
    for (int i = F.tid; i < 8192; i += NTHR) RW[i] = rw[i];
    if (F.tid < 8) HC[F.tid] = 0;
    __syncthreads();
    unsigned* topk = WSP(unsigned, WS_ROUTE + RT_TOPK);
    for (int rr = 0; rr < 8; ++rr) {
        const int t = F.bid * 64 + F.wave * 8 + rr;
        f32x4 v[4]; rms_row(x + (size_t)t * D, g, out + (size_t)t * D, F.lane, v);
        float lg[8];
#pragma unroll
        for (int e = 0; e < 8; ++e) lg[e] = 0.f;
#pragma unroll
        for (int j = 0; j < 4; ++j)
#pragma unroll
            for (int q = 0; q < 4; ++q) { const int k = 4 * (64 * j + F.lane) + q; const f32x4 w0 = *(const LAS f32x4*)(RW + k * 8), w1 = *(const LAS f32x4*)(RW + k * 8 + 4); const float xv = v[j][q];
                lg[0] += xv * w0.x; lg[1] += xv * w0.y; lg[2] += xv * w0.z; lg[3] += xv * w0.w; lg[4] += xv * w1.x; lg[5] += xv * w1.y; lg[6] += xv * w1.z; lg[7] += xv * w1.w; }
#pragma unroll
        for (int e = 0; e < 8; ++e) lg[e] = wave_sum(lg[e]);
        int i0 = 0; float m0 = lg[0];
#pragma unroll
        for (int e = 1; e < 8; ++e) if (lg[e] > m0) { m0 = lg[e]; i0 = e; }
        int i1 = -1; float m1 = -3.0e38f;
#pragma unroll
        for (int e = 0; e < 8; ++e) if (e != i0 && lg[e] > m1) { m1 = lg[e]; i1 = e; }
        const float e1 = expf(m1 - m0), den = 1.f + e1;
        if (F.lane == 0) { u32x4 o; o.x = (unsigned)i0; o.y = (unsigned)i1; o.z = __float_as_uint(1.f / den); o.w = __float_as_uint(e1 / den); *(u32x4*)(topk + 4 * t) = o;
            atomicAdd((int*)&HC[i0], 1); atomicAdd((int*)&HC[i1], 1); }
    }
    __syncthreads();
    if (F.tid < 8) WSP(int, WS_ROUTE + RT_CNT)[F.bid * 8 + F.tid] = HC[F.tid];
}
__device__ __forceinline__ void assign_phase(Frame& F) {
    LAS int* SB = (LAS int*)F.lds;
    const int* cnt = WSP(int, WS_ROUTE + RT_CNT);
    const unsigned* topk = WSP(unsigned, WS_ROUTE + RT_TOPK);
    int* rowidx = WSP(int, WS_ROUTE + RT_ROWIDX); int* tokslot = WSP(int, WS_ROUTE + RT_TOKSLOT);
    if (F.tid < 8) { int before = 0, tot = 0; for (int b = 0; b < F.G; ++b) { const int c = cnt[b * 8 + F.tid]; tot += c; if (b < F.bid) before += c; } SB[F.tid] = before; SB[16 + F.tid] = tot; }
    __syncthreads();
    if (F.tid == 0) { int off = 0; for (int e = 0; e < 8; ++e) { SB[8 + e] = off; off += (SB[16 + e] + 255) & ~255; } SB[24] = off; }
    __syncthreads();
    if (F.tid < 8) { const int e = F.tid; int run = SB[8 + e] + SB[e];
        for (int i = 0; i < 64; ++i) { const int t = F.bid * 64 + i; const unsigned e0 = topk[4 * t], e1 = topk[4 * t + 1];
            if ((int)e0 == e) { rowidx[run] = t; tokslot[2 * t] = run; ++run; }
            if ((int)e1 == e) { rowidx[run] = t; tokslot[2 * t + 1] = run; ++run; } } }
    if (F.bid < 8) { const int e = F.bid, lo = SB[8 + e] + SB[16 + e], hi = SB[8 + e] + ((SB[16 + e] + 255) & ~255); for (int s = lo + F.tid; s < hi; s += NTHR) rowidx[s] = 0; }
    if (F.bid == 0) { int* tile_e = WSP(int, WS_ROUTE + RT_TILEE); const int nt = SB[24] >> 8;
        for (int i = F.tid; i < nt; i += NTHR) { int e = 0; for (int q = 1; q < 8; ++q) if (i * 256 >= SB[8 + q]) e = q; tile_e[i] = e; }
        if (F.tid == 0) WSP(int, WS_ROUTE + RT_NT)[0] = nt; }
}
struct MoeUpSched {
    pg8::TileOrder o; const char* A; const char* Bt; const int* tile_e; const int* rowidx;
    __device__ __forceinline__ bool next(int i, pg8::Unit& u) const { if (!o.tile(i, u.pm, u.pn)) return false; const int e = tile_e[u.pm]; u.a = A; u.b = Bt + ((size_t)e * 2 * DFE + (size_t)u.pn * 256) * D * 2; return true; }
    __device__ __forceinline__ unsigned arow(const pg8::Unit& u, int r) const { return (unsigned)rowidx[u.pm * 256 + r]; }
};
struct MoeDnSched {
    pg8::TileOrder o; const char* A; const char* Bt; const int* tile_e;
    __device__ __forceinline__ bool next(int i, pg8::Unit& u) const { if (!o.tile(i, u.pm, u.pn)) return false; const int e = tile_e[u.pm]; u.a = A + (size_t)u.pm * 256 * DFE * 2; u.b = Bt + ((size_t)e * D + (size_t)u.pn * 256) * DFE * 2; return true; }
    __device__ __forceinline__ unsigned arow(const pg8::Unit&, int) const { return 0u; }
};
__device__ __forceinline__ void final_phase(Frame& F, const float* x, const bf16* ybuf, const float* g, float* out) {
    const int gw = F.bid * NWAVES + F.wave, NGW = F.G * NWAVES;
    const unsigned* topk = WSP(unsigned, WS_ROUTE + RT_TOPK); const int* tokslot = WSP(int, WS_ROUTE + RT_TOKSLOT);
    for (int t = gw; t < L; t += NGW) {
        const float g0 = __uint_as_float(topk[4 * t + 2]), g1 = __uint_as_float(topk[4 * t + 3]); const int s0 = tokslot[2 * t], s1 = tokslot[2 * t + 1];
        const f32x4* xr = (const f32x4*)(x + (size_t)t * D) + F.lane; const u32x2* y0 = (const u32x2*)(ybuf + (size_t)s0 * D) + F.lane; const u32x2* y1 = (const u32x2*)(ybuf + (size_t)s1 * D) + F.lane;
        f32x4 v[4]; float s = 0.f;
#pragma unroll
        for (int j = 0; j < 4; ++j) { const u32x2 a = y0[64 * j], b = y1[64 * j]; v[j] = xr[64 * j];
            v[j].x += g0 * bflo(a.x) + g1 * bflo(b.x); v[j].y += g0 * bfhi(a.x) + g1 * bfhi(b.x); v[j].z += g0 * bflo(a.y) + g1 * bflo(b.y); v[j].w += g0 * bfhi(a.y) + g1 * bfhi(b.y);
            s += (v[j].x * v[j].x + v[j].y * v[j].y) + (v[j].z * v[j].z + v[j].w * v[j].w); }
        const float r = 1.0f / sqrtf(wave_sum(s) * (1.f / D) + EPS);
        f32x4* o = (f32x4*)(out + (size_t)t * D) + F.lane;
#pragma unroll
        for (int j = 0; j < 4; ++j) o[64 * j] = v[j] * r * ((const f32x4*)g)[64 * j + F.lane];
    }
}
__device__ __forceinline__ u32x4 ld16(const bf16* p) { return *(const u32x4*)p; }
__device__ __forceinline__ u32x2 ld8(const bf16* p) { return *(const u32x2*)p; }

__device__ __forceinline__ void mixer_a(Frame& F, int l, int b) {
    const bf16* P = WSP(bf16, WS_PROJ); bf16* Y = WSP(bf16, WS_YCAT); const float* cw = F.in[4] + (size_t)l * 3 * 512;
    const int c0 = 8 * F.lane, tb = 64 * b + 8 * F.wave;
    float w0[8], w1[8], w2[8];
#pragma unroll
    for (int j = 0; j < 8; ++j) { w0[j] = cw[c0 + j]; w1[j] = cw[512 + c0 + j]; w2[j] = cw[1024 + c0 + j]; }
    float pm2[8], pm1[8];
#pragma unroll
    for (int r = -2; r < 8; ++r) {
        const int t = tb + r; float pr[8];
        if (t >= 0) { float ah[8], ac[8]; unpack8(ld16(P + (size_t)t * PW + c0), ah); unpack8(ld16(P + (size_t)t * PW + 1024 + c0), ac);
#pragma unroll
            for (int j = 0; j < 8; ++j) pr[j] = ah[j] * ac[j]; }
        else {
#pragma unroll
            for (int j = 0; j < 8; ++j) pr[j] = 0.f; }
        if (r >= 0) { float ab[8], o[8]; unpack8(ld16(P + (size_t)t * PW + 512 + c0), ab);
#pragma unroll
            for (int j = 0; j < 8; ++j) o[j] = ab[j] * (w0[j] * pm2[j] + w1[j] * pm1[j] + w2[j] * pr[j]);
            *(u32x4*)(Y + (size_t)t * YW + c0) = pack8(o); }
#pragma unroll
        for (int j = 0; j < 8; ++j) { pm2[j] = pm1[j]; pm1[j] = pr[j]; }
    }
}

__device__ __forceinline__ void mixer_d(Frame& F, int l, int b) {
    const bf16* P = WSP(bf16, WS_PROJ); bf16* Y = WSP(bf16, WS_YCAT);
    LAS unsigned char* RAW = F.lds;
    LAS unsigned char* PL = F.lds + 20480;
    const int t0 = 64 * b, fr = F.lane & 15, fq = F.lane >> 4;
    for (int g = 0; g < 4; ++g) {
        const int win = 2 << g;
        for (int i = F.tid; i < 79 * 16; i += NTHR) { const int r = i >> 4, c8 = i & 15, t = t0 - 15 + r;
            u32x4 v = (u32x4){0u, 0u, 0u, 0u}; if (t >= 0) v = ld16(P + (size_t)t * PW + 5632 + g * 128 + 8 * c8);
            *(LAS u32x4*)(RAW + r * 256 + c8 * 16) = v; }
        __syncthreads();
        for (int i = F.tid; i < 64 * 16; i += NTHR) { const int r = i >> 4, c8 = i & 15, t = t0 + r;
            float s[8], x0[8];
#pragma unroll
            for (int j = 0; j < 8; ++j) s[j] = 0.f;
            for (int k = 0; k < win; ++k) { float x[8]; unpack8(*(const LAS u32x4*)(RAW + (r + 15 - k) * 256 + c8 * 16), x);
#pragma unroll
                for (int j = 0; j < 8; ++j) s[j] += x[j];
                if (k == 0) {
#pragma unroll
                    for (int j = 0; j < 8; ++j) x0[j] = x[j]; } }
            const float inv = 1.0f / (float)((t + 1 < win) ? t + 1 : win);
#pragma unroll
            for (int j = 0; j < 8; ++j) s[j] = s[j] * inv - x0[j];
            *(LAS u32x4*)(PL + r * 272 + c8 * 16) = pack8(s); }
        __syncthreads();
        const bf16* Q = WSP(bf16, WS_SMALL + SM_POOLT) + ((size_t)l * 4 + g) * 128 * 128 + (size_t)(16 * F.wave + fr) * 128 + 8 * fq;
        f32x4 acc[4];
#pragma unroll
        for (int m = 0; m < 4; ++m) acc[m] = (f32x4){0.f, 0.f, 0.f, 0.f};
#pragma unroll
        for (int kk = 0; kk < 4; ++kk) { const bf16x8 q = gfrag(Q + 32 * kk);
#pragma unroll
            for (int m = 0; m < 4; ++m) { const bf16x8 p = ldsfrag(PL, (16 * m + fr) * 272 + (32 * kk + 8 * fq) * 2); MMA16(acc[m], q, p); } }
        const int d0 = 16 * F.wave + 4 * fq; const f32x4 sc = *(const f32x4*)(F.in[16] + (size_t)l * 512 + g * 128 + d0);
#pragma unroll
        for (int m = 0; m < 4; ++m) { const f32x4 v = acc[m] * sc; u32x2 w; w.x = cvt_pk_bf16(v[0], v[1]); w.y = cvt_pk_bf16(v[2], v[3]);
            *(u32x2*)(Y + (size_t)(t0 + 16 * m + fr) * YW + 2048 + g * 128 + d0) = w; }
        __syncthreads();
    }
}

__device__ __forceinline__ void mixer_c(Frame& F, int l, int blk, int gp) {
    const bf16* P = WSP(bf16, WS_PROJ); bf16* Y = WSP(bf16, WS_YCAT);
    LAS float* MU = (LAS float*)F.lds; LAS float* RS = (LAS float*)(F.lds + 512); LAS unsigned char* VT = F.lds + 1024;
    const int t0 = 128 * blk, fr = F.lane & 15, fq = F.lane >> 4;
    for (int i = 0; i < 16; ++i) { const int row = 16 * F.wave + i; float x[8]; unpack8(ld16(P + (size_t)(t0 + row) * PW + 5120 + 8 * F.lane), x);
        float s = 0.f, q = 0.f;
#pragma unroll
        for (int j = 0; j < 8; ++j) { s += x[j]; q += x[j] * x[j]; }
        s = wave_sum(s); q = wave_sum(q);
        if (F.lane == 0) { const float mu = s * (1.f / 512.f); const float var = fmaxf(q * (1.f / 512.f) - mu * mu, 0.f); MU[row] = mu; RS[row] = 1.0f / sqrtf(var + EPS); } }
    __syncthreads();
    { const int ch8 = F.lane & 31, par = F.lane >> 5, cv = gp * 256 + 8 * ch8;
      float lg[8], lb[8];
#pragma unroll
      for (int j = 0; j < 8; ++j) { lg[j] = F.in[11][(size_t)l * 512 + cv + j]; lb[j] = F.in[12][(size_t)l * 512 + cv + j]; }
      for (int i = 0; i < 8; ++i) { const int row = 16 * F.wave + 2 * i + par; float x[8]; unpack8(ld16(P + (size_t)(t0 + row) * PW + 5120 + cv), x);
          const float mu = MU[row], rs = RS[row];
#pragma unroll
          for (int j = 0; j < 8; ++j) *(LAS bf16*)(VT + (8 * ch8 + j) * 272 + row * 2) = f2bf((x[j] - mu) * rs * lg[j] + lb[j]); } }
    __syncthreads();
    const int g = 2 * gp + (F.wave >> 2);
    const bf16* Wm = WSP(bf16, WS_SMALL + SM_GMW) + ((size_t)l * 4 + g) * 128 * 128;
    f32x4 acc[8][2];
#pragma unroll
    for (int m = 0; m < 8; ++m) { acc[m][0] = (f32x4){0.f, 0.f, 0.f, 0.f}; acc[m][1] = (f32x4){0.f, 0.f, 0.f, 0.f}; }
#pragma unroll
    for (int m = 0; m < 8; ++m) {
#pragma unroll
        for (int kk = 0; kk < 4; ++kk) if (kk <= (m >> 1)) { const bf16x8 p = gfrag(Wm + (size_t)(16 * m + fr) * 128 + 32 * kk + 8 * fq);
#pragma unroll
            for (int x = 0; x < 2; ++x) { const bf16x8 q = ldsfrag(VT, (16 * (2 * F.wave + x) + fr) * 272 + (32 * kk + 8 * fq) * 2); MMA16(acc[m][x], q, p); } } }
#pragma unroll
    for (int m = 0; m < 8; ++m) { const int tl = 16 * m + fr; const float bias = F.in[14][((size_t)l * 4 + g) * 128 + tl];
#pragma unroll
        for (int x = 0; x < 2; ++x) { const int cl = 16 * ((2 * F.wave + x) & 7) + 4 * fq; const u32x2 u = ld8(P + (size_t)(t0 + tl) * PW + 4608 + g * 128 + cl);
            const f32x4 a = acc[m][x]; u32x2 w; w.x = cvt_pk_bf16(bflo(u.x) * (a[0] + bias), bfhi(u.x) * (a[1] + bias)); w.y = cvt_pk_bf16(bflo(u.y) * (a[2] + bias), bfhi(u.y) * (a[3] + bias));
            *(u32x2*)(Y + (size_t)(t0 + tl) * YW + 1536 + g * 128 + cl) = w; } }
    __syncthreads();
}

constexpr int S1_DTV = 0, S1_DAC = 4096, S1_WV = 8192, S1_RED = 12288, S1_CL = 12288, S1_BL = 29696, S1_BT = 47104, S1_XT = 65536, S1_SH = 102400;
__device__ __forceinline__ void ssd1_chunk(Frame& F, int l, int c) {
    const bf16* P = WSP(bf16, WS_PROJ); bf16* Y = WSP(bf16, WS_YCAT); const bf16* H = WSP(bf16, WS_H);
    LAS unsigned char* lds = F.lds; LAS float* DTV = (LAS float*)(lds + S1_DTV); LAS float* DAC = (LAS float*)(lds + S1_DAC); LAS float* WV = (LAS float*)(lds + S1_WV); LAS float* RED = (LAS float*)(lds + S1_RED);
    const int t0 = 64 * c, fr = F.lane & 15, fq = F.lane >> 4, wave = F.wave, lane = F.lane;
    { f32x4 acc[4];
#pragma unroll
      for (int m = 0; m < 4; ++m) acc[m] = (f32x4){0.f, 0.f, 0.f, 0.f};
      const bf16* Hp = H + (size_t)(t0 + fr) * D + wave * 128 + 8 * fq; const bf16* Wd = WSP(bf16, WS_SMALL + SM_WDT) + (size_t)l * 16384 + fr * 1024 + wave * 128 + 8 * fq;
#pragma unroll
      for (int kk = 0; kk < 4; ++kk) { const bf16x8 q = gfrag(Wd + 32 * kk);
#pragma unroll
          for (int m = 0; m < 4; ++m) { const bf16x8 p = gfrag(Hp + (size_t)(16 * m) * D + 32 * kk); MMA16(acc[m], q, p); } }
#pragma unroll
      for (int m = 0; m < 4; ++m) *(LAS f32x4*)(RED + (wave * 64 + 16 * m + fr) * 16 + 4 * fq) = acc[m]; }
    __syncthreads();
    for (int o = F.tid; o < 1024; o += NTHR) { float s = 0.f;
#pragma unroll
        for (int w = 0; w < 8; ++w) s += RED[w * 1024 + o];
        const int j = o & 15; const float dt = softplus_f(s + F.in[7][l * 16 + j]); DTV[o] = dt; DAC[o] = -expf(F.in[8][l * 16 + j]) * dt; }
    __syncthreads();
    if (F.tid < 16) { float run = 0.f; for (int t = 0; t < 64; ++t) { run += DAC[t * 16 + F.tid]; DAC[t * 16 + F.tid] = run; } }
    __syncthreads();
    for (int o = F.tid; o < 1024; o += NTHR) { const int j = o & 15; WV[o] = DTV[o] * expf(DAC[63 * 16 + j] - DAC[o]); WSP(float, WS_DACS)[(size_t)t0 * 16 + o] = DAC[o]; }
    __syncthreads();
    for (int g = 0; g < 4; ++g) {
        { const int chx = lane < 32 ? g * 256 + 8 * lane : (lane < 48 ? 1024 + g * 128 + 8 * (lane - 32) : 1536 + g * 128 + 8 * (lane - 48));
          const float* cw = F.in[5] + (size_t)l * 4 * 2048 + chx; const float* cb = F.in[6] + (size_t)l * 2048 + chx;
          float w0[8], w1[8], w2[8], w3[8], bi[8];
#pragma unroll
          for (int j = 0; j < 8; ++j) { w0[j] = cw[j]; w1[j] = cw[2048 + j]; w2[j] = cw[4096 + j]; w3[j] = cw[6144 + j]; bi[j] = cb[j]; }
          u32x4 raw[11];
#pragma unroll
          for (int r = 0; r < 11; ++r) { const int t = t0 + 8 * wave + r - 3; raw[r] = (u32x4){0u, 0u, 0u, 0u}; if (t >= 0) raw[r] = ld16(P + (size_t)t * PW + 2560 + chx); }
          float x3[8], x2[8], x1[8]; unpack8(raw[0], x3); unpack8(raw[1], x2); unpack8(raw[2], x1);
          float prev[8];
#pragma unroll
          for (int r = 0; r < 8; ++r) { float x0[8], o[8]; unpack8(raw[3 + r], x0); const int row = 8 * wave + r;
#pragma unroll
              for (int j = 0; j < 8; ++j) { o[j] = silu_f(bi[j] + w0[j] * x3[j] + w1[j] * x2[j] + w2[j] * x1[j] + w3[j] * x0[j]); x3[j] = x2[j]; x2[j] = x1[j]; x1[j] = x0[j]; }
              if (lane >= 48) { const u32x4 pk = pack8(o); const int n0 = 8 * (lane - 48); *(LAS u32x4*)(lds + S1_CL + row * 272 + n0 * 2) = pk; *(u32x4*)(WSP(bf16, WS_CC) + (size_t)(t0 + row) * 512 + g * 128 + n0) = pk; }
              else if (lane >= 32) { const int n0 = 8 * (lane - 32); *(LAS u32x4*)(lds + S1_BL + row * 272 + n0 * 2) = pack8(o);
                  if (r & 1) {
#pragma unroll
                      for (int j = 0; j < 8; ++j) *(LAS unsigned*)(lds + S1_BT + (n0 + j) * 144 + (row - 1) * 2) = cvt_pk_bf16(prev[j], o[j]); } }
              else { const int hl = lane >> 3, p0 = 8 * (lane & 7);
                  if (r & 1) {
#pragma unroll
                      for (int j = 0; j < 8; ++j) *(LAS unsigned*)(lds + S1_XT + ((hl * 64 + p0 + j) * 72 + (row - 1)) * 2) = cvt_pk_bf16(prev[j], o[j]); } }
#pragma unroll
              for (int j = 0; j < 8; ++j) prev[j] = o[j]; } }
        __syncthreads();
        { const int mi = wave >> 1, nb = (wave & 1) * 2;
          f32x4 cbv[2] = {(f32x4){0.f, 0.f, 0.f, 0.f}, (f32x4){0.f, 0.f, 0.f, 0.f}};
#pragma unroll
          for (int kk = 0; kk < 4; ++kk) { const bf16x8 p = ldsfrag(lds, S1_CL + (16 * mi + fr) * 272 + (32 * kk + 8 * fq) * 2);
#pragma unroll
              for (int x = 0; x < 2; ++x) if (nb + x <= mi) { const bf16x8 q = ldsfrag(lds, S1_BL + (16 * (nb + x) + fr) * 272 + (32 * kk + 8 * fq) * 2); MMA16(cbv[x], q, p); } }
          const int lrow = 16 * mi + fr;
#pragma unroll
          for (int hl = 0; hl < 4; ++hl) { const int hh = 4 * g + hl; const float dl = DAC[lrow * 16 + hh];
#pragma unroll
              for (int x = 0; x < 2; ++x) { const int s0 = 16 * (nb + x) + 4 * fq; float v[4];
#pragma unroll
                  for (int r = 0; r < 4; ++r) { const int s = s0 + r; const bool ok = (nb + x <= mi) && (s <= lrow); const float e = ok ? fast_exp(fminf(dl - DAC[s * 16 + hh], 0.f)) * DTV[s * 16 + hh] : 0.f; v[r] = ok ? cbv[x][r] * e : 0.f; }
                  u32x2 w; w.x = cvt_pk_bf16(v[0], v[1]); w.y = cvt_pk_bf16(v[2], v[3]);
                  *(LAS u32x2*)(lds + S1_SH + ((hl * 64 + lrow) * 72 + s0) * 2) = w; } } }
        __syncthreads();
        { const int hl = wave >> 1, hh = 4 * g + hl;
          const float dsk = F.in[9][l * 16 + hh];
#pragma unroll
          for (int m2 = 0; m2 < 2; ++m2) { const int mi = 2 * (wave & 1) + m2, nk = (mi >> 1) + 1;
              f32x4 y[4];
#pragma unroll
              for (int pi = 0; pi < 4; ++pi) y[pi] = (f32x4){0.f, 0.f, 0.f, 0.f};
#pragma unroll
              for (int kk = 0; kk < 2; ++kk) if (kk < nk) { const bf16x8 p = ldsfrag(lds, S1_SH + ((hl * 64 + 16 * mi + fr) * 72 + 32 * kk + 8 * fq) * 2);
#pragma unroll
                  for (int pi = 0; pi < 4; ++pi) { const bf16x8 q = ldsfrag(lds, S1_XT + ((hl * 64 + 16 * pi + fr) * 72 + 32 * kk + 8 * fq) * 2); MMA16(y[pi], q, p); } }
              const int lrow = 16 * mi + fr;
#pragma unroll
              for (int pi = 0; pi < 4; ++pi) { const int p0 = 16 * pi + 4 * fq; float xs[4];
#pragma unroll
                  for (int r = 0; r < 4; ++r) xs[r] = bf1(*(const LAS bf16*)(lds + S1_XT + ((hl * 64 + p0 + r) * 72 + lrow) * 2));
                  u32x2 w; w.x = cvt_pk_bf16(y[pi][0] + dsk * xs[0], y[pi][1] + dsk * xs[1]); w.y = cvt_pk_bf16(y[pi][2] + dsk * xs[2], y[pi][3] + dsk * xs[3]);
                  *(u32x2*)(Y + (size_t)(t0 + lrow) * YW + 512 + hh * 64 + p0) = w; } }
          f32x4 st[4][4];
#pragma unroll
          for (int pi = 0; pi < 4; ++pi)
#pragma unroll
              for (int nx = 0; nx < 4; ++nx) st[pi][nx] = (f32x4){0.f, 0.f, 0.f, 0.f};
#pragma unroll
          for (int kk = 0; kk < 2; ++kk) { float wv[8];
#pragma unroll
              for (int j = 0; j < 8; ++j) wv[j] = WV[(32 * kk + 8 * fq + j) * 16 + hh];
              bf16x8 pa[4];
#pragma unroll
              for (int pi = 0; pi < 4; ++pi) { float xv[8]; unpack8(*(const LAS u32x4*)(lds + S1_XT + ((hl * 64 + 16 * pi + fr) * 72 + 32 * kk + 8 * fq) * 2), xv);
#pragma unroll
                  for (int j = 0; j < 8; ++j) xv[j] *= wv[j];
                  const u32x4 pk = pack8(xv); pa[pi] = __builtin_bit_cast(bf16x8, pk); }
#pragma unroll
              for (int nx = 0; nx < 4; ++nx) { const bf16x8 q = ldsfrag(lds, S1_BT + (16 * (4 * (wave & 1) + nx) + fr) * 144 + (32 * kk + 8 * fq) * 2);
#pragma unroll
                  for (int pi = 0; pi < 4; ++pi) MMA16(st[pi][nx], q, pa[pi]); } }
          bf16* ST = WSP(bf16, WS_STATES) + ((size_t)c * 16 + hh) * 8192;
#pragma unroll
          for (int pi = 0; pi < 4; ++pi)
#pragma unroll
              for (int nx = 0; nx < 4; ++nx) { const f32x4 v = st[pi][nx]; u32x2 w; w.x = cvt_pk_bf16(v[0], v[1]); w.y = cvt_pk_bf16(v[2], v[3]);
                  *(u32x2*)(ST + (size_t)(16 * pi + fr) * 128 + 16 * (4 * (wave & 1) + nx) + 4 * fq) = w; } }
        __syncthreads();
    }
}

__device__ __forceinline__ void scan_phase(Frame& F) {
    const int e = F.bid * NTHR + F.tid, hh = e >> 13;
    bf16* ST = WSP(bf16, WS_STATES) + e; const float* DA = WSP(float, WS_DACS) + 63 * 16 + hh;
    float run = 0.f;
    for (int cb = 0; cb < 256; cb += 16) { bf16 s[16]; float d[16];
#pragma unroll
        for (int i = 0; i < 16; ++i) { s[i] = ST[(size_t)(cb + i) * 131072]; d[i] = DA[(size_t)(cb + i) * 64 * 16]; }
#pragma unroll
        for (int i = 0; i < 16; ++i) { ST[(size_t)(cb + i) * 131072] = f2bf(run); run = run * expf(d[i]) + bf1(s[i]); } }
}

__device__ __forceinline__ void ssd3_chunk(Frame& F, int l, int c) {
    const bf16* P = WSP(bf16, WS_PROJ); bf16* Y = WSP(bf16, WS_YCAT); const bf16* CCp = WSP(bf16, WS_CC); const float* DACS = WSP(float, WS_DACS);
    LAS float* SQ = (LAS float*)F.lds;
    const int t0 = 64 * c, fr = F.lane & 15, fq = F.lane >> 4, wave = F.wave;
    for (int g = 0; g < 4; ++g) {
        const int hl = wave >> 1, hh = 4 * g + hl, pb = 2 * (wave & 1);
        const bf16* HI = WSP(bf16, WS_STATES) + ((size_t)c * 16 + hh) * 8192;
        bf16x8 hq[2][4];
#pragma unroll
        for (int px = 0; px < 2; ++px)
#pragma unroll
            for (int kk = 0; kk < 4; ++kk) hq[px][kk] = gfrag(HI + (size_t)(16 * (pb + px) + fr) * 128 + 32 * kk + 8 * fq);
        f32x4 y[4][2];
#pragma unroll
        for (int mi = 0; mi < 4; ++mi) { y[mi][0] = (f32x4){0.f, 0.f, 0.f, 0.f}; y[mi][1] = (f32x4){0.f, 0.f, 0.f, 0.f};
#pragma unroll
            for (int kk = 0; kk < 4; ++kk) { const bf16x8 p = gfrag(CCp + (size_t)(t0 + 16 * mi + fr) * 512 + g * 128 + 32 * kk + 8 * fq);
#pragma unroll
                for (int px = 0; px < 2; ++px) MMA16(y[mi][px], hq[px][kk], p); } }
#pragma unroll
        for (int mi = 0; mi < 4; ++mi) { const int t = t0 + 16 * mi + fr; const float e = expf(DACS[(size_t)t * 16 + hh]); float sq = 0.f;
#pragma unroll
            for (int px = 0; px < 2; ++px) { const int ch = hh * 64 + 16 * (pb + px) + 4 * fq; const u32x2 yd = ld8(Y + (size_t)t * YW + 512 + ch), z = ld8(P + (size_t)t * PW + 1536 + ch);
                f32x4 v; v[0] = (bflo(yd.x) + e * y[mi][px][0]) * silu_f(bflo(z.x)); v[1] = (bfhi(yd.x) + e * y[mi][px][1]) * silu_f(bfhi(z.x));
                v[2] = (bflo(yd.y) + e * y[mi][px][2]) * silu_f(bflo(z.y)); v[3] = (bfhi(yd.y) + e * y[mi][px][3]) * silu_f(bfhi(z.y));
                y[mi][px] = v; sq += (v[0] * v[0] + v[1] * v[1]) + (v[2] * v[2] + v[3] * v[3]); }
            sq += __shfl_xor(sq, 16); sq += __shfl_xor(sq, 32);
            if (fq == 0) SQ[wave * 64 + 16 * mi + fr] = sq; }
        __syncthreads();
#pragma unroll
        for (int mi = 0; mi < 4; ++mi) { const int lr = 16 * mi + fr, t = t0 + lr; float tot = 0.f;
#pragma unroll
            for (int w = 0; w < 8; ++w) tot += SQ[w * 64 + lr];
            const float rstd = 1.0f / sqrtf(tot * (1.f / 256.f) + EPS);
#pragma unroll
            for (int px = 0; px < 2; ++px) { const int ch = hh * 64 + 16 * (pb + px) + 4 * fq; const f32x4 ng = *(const f32x4*)(F.in[10] + (size_t)l * 1024 + ch); const f32x4 v = y[mi][px] * rstd * ng;
                u32x2 w; w.x = cvt_pk_bf16(v[0], v[1]); w.y = cvt_pk_bf16(v[2], v[3]); *(u32x2*)(Y + (size_t)t * YW + 512 + ch) = w; } }
        __syncthreads();
    }
}
struct Args { const float* in[31]; float* out; unsigned char* ws; int ph_lo, ph_hi; };
constexpr int PH_PER_LAYER = 12, N_PHASES = 2 + 2 * PH_PER_LAYER;

#ifndef PMASK
#define PMASK 0x3fff
#endif
#define IN(k) (lo <= (k) && (k) < hi)
#define EN(b) ((PMASK >> (b)) & 1)
#define PHASE_BEGIN() do { int _t = threadIdx.x; asm volatile("" : "+v"(_t)); F.tid = _t; F.lane = _t & 63; } while (0)
#define SEAM(k) do { if (IN((k) + 1) && MK_N_LAUNCHES == 1) xcd_barrier(bar); } while (0)
template <int l> __device__ __forceinline__ void layer_phases(Frame& F, const XcdBarrier& bar, const int lo, const int hi) {
    const int gw = F.bid * NWAVES + F.wave, NGW = F.G * NWAVES;
    LAS unsigned char* ring = F.lds;
        const int pb = 1 + PH_PER_LAYER * l;
        const float* xin = (l == 0) ? F.in[0] : WSP(float, WS_XC);
        const bf16* W1T = WSP(bf16, WS_W1T) + (size_t)l * 10240 * D;
        if (EN(1) && IN(pb + 0) && l == 1) { PHASE_BEGIN(); rmsnorm_phase(F, xin, F.in[1] + D, WSP(bf16, WS_H)); SEAM(pb + 0); }
        if (EN(2) && IN(pb + 1)) { PHASE_BEGIN();
            pg8::DenseSched S; S.init(WSP(bf16, WS_H), W1T, L, PW, D, F.G, F.bid);
            pg8::EpiBf16Act E{WSP(bf16, WS_PROJ), PW, 18, 22, 0};
            pg8::gemm_phase<pg8::EpiBf16Act, pg8::DenseSched, true, false>(ring, D, S, E);
            SEAM(pb + 1);
        }
        if (EN(3) && IN(pb + 2)) { PHASE_BEGIN();
#ifndef MIXMASK
#define MIXMASK 15
#endif
            if (MIXMASK & 1) ssd1_chunk(F, l, F.bid);
            if (MIXMASK & 2) mixer_c(F, l, F.bid >> 1, F.bid & 1);
            if (MIXMASK & 4) mixer_d(F, l, F.bid);
            if (MIXMASK & 8) mixer_a(F, l, F.bid);
            SEAM(pb + 2);
        }
        if (EN(4) && IN(pb + 3)) { PHASE_BEGIN(); scan_phase(F); SEAM(pb + 3); }
        if (EN(5) && IN(pb + 4)) { PHASE_BEGIN(); ssd3_chunk(F, l, F.bid); SEAM(pb + 4); }
        if (EN(6) && IN(pb + 5)) { PHASE_BEGIN();
            pg8::DenseSched S; S.init(WSP(bf16, WS_H), W1T + (size_t)PW * D, L, GW, D, F.G, F.bid);
            pg8::EpiBf16Act E{WSP(bf16, WS_GATES), GW, 0, 0, 1};
            pg8::gemm_phase<pg8::EpiBf16Act, pg8::DenseSched, true, false>(ring, D, S, E);
            SEAM(pb + 5);
        }
        if (EN(7) && IN(pb + 6)) { PHASE_BEGIN();
            pg8::DenseSched S; S.init(WSP(bf16, WS_YCAT), WSP(bf16, WS_BRT) + (size_t)l * D * YW, L, D, YW, F.G, F.bid);
            pg8::EpiMerge E{WSP(bf16, WS_GATES), WSP(bf16, WS_MERGED)};
            pg8::gemm_phase<pg8::EpiMerge, pg8::DenseSched, false, false>(ring, YW, S, E);
            SEAM(pb + 6);
        }
        if (EN(8) && IN(pb + 7)) { PHASE_BEGIN();
            pg8::DenseSched S; S.init(WSP(bf16, WS_MERGED), WSP(bf16, WS_OUTT) + (size_t)l * D * D, L, D, D, F.G, F.bid);
            pg8::EpiResid E{xin, WSP(float, WS_XC), D};
            pg8::gemm_phase<pg8::EpiResid, pg8::DenseSched, false, false>(ring, D, S, E);
            SEAM(pb + 7);
        }
        if (EN(9) && IN(pb + 8)) { PHASE_BEGIN();
            if (l == 0) rmsnorm_phase(F, WSP(float, WS_XC), F.in[22], WSP(bf16, WS_H2));
            else { route_phase(F, WSP(float, WS_XC), F.in[22] + D, WSP(bf16, WS_H2), F.in[26]); __syncthreads(); convert_moe_weights(F, gw, NGW); }
            SEAM(pb + 8);
        }
        if (EN(10) && IN(pb + 9) && l == 1) { PHASE_BEGIN(); assign_phase(F); SEAM(pb + 9); }
        if (EN(11) && IN(pb + 10)) { PHASE_BEGIN();
            if (l == 0) {
                pg8::DenseSched S; S.init(WSP(bf16, WS_H2), WSP(bf16, WS_UPT), L, 2 * DFF, D, F.G, F.bid);
                pg8::EpiSwiglu E{WSP(bf16, WS_ACT), DFF};
                pg8::gemm_phase<pg8::EpiSwiglu, pg8::DenseSched, true, false>(ring, D, S, E);
            } else {
                MoeUpSched S; S.o.init(WSP(int, WS_ROUTE + RT_NT)[0], 2 * DFE / 256, F.G, F.bid); S.A = (const char*)WSP(bf16, WS_H2); S.Bt = (const char*)WSP(bf16, WS_MOEUP);
                S.tile_e = WSP(int, WS_ROUTE + RT_TILEE); S.rowidx = WSP(int, WS_ROUTE + RT_ROWIDX);
                pg8::EpiSwiglu E{WSP(bf16, WS_ACTM), DFE};
                pg8::gemm_phase<pg8::EpiSwiglu, MoeUpSched, true, true>(ring, D, S, E);
            }
            SEAM(pb + 10);
        }
        if (EN(12) && IN(pb + 11)) { PHASE_BEGIN();
            if (l == 0) {
                pg8::DenseSched S; S.init(WSP(bf16, WS_ACT), WSP(bf16, WS_DNT), L, D, DFF, F.G, F.bid);
                pg8::EpiResid E{WSP(float, WS_XC), WSP(float, WS_XC), D};
                pg8::gemm_phase<pg8::EpiResid, pg8::DenseSched, false, false>(ring, DFF, S, E);
            } else {
                MoeDnSched S; S.o.init(WSP(int, WS_ROUTE + RT_NT)[0], D / 256, F.G, F.bid); S.A = (const char*)WSP(bf16, WS_ACTM); S.Bt = (const char*)WSP(bf16, WS_MOEDN); S.tile_e = WSP(int, WS_ROUTE + RT_TILEE);
                pg8::EpiBf16Act E{WSP(bf16, WS_YBUF), D, 0, 0, 0};
                pg8::gemm_phase<pg8::EpiBf16Act, MoeDnSched, true, false>(ring, DFE, S, E);
            }
            SEAM(pb + 11);
        }

}
__global__ void __launch_bounds__(NTHR, 2) fwd_kernel(Args args) {
    extern __shared__ __attribute__((aligned(16))) unsigned char lds_raw[];
    Frame F;
    F.lds = (LAS unsigned char*)lds_raw;
    F.MISC = (volatile LAS unsigned*)(F.lds + MISC_OFF);
    F.tid = threadIdx.x; F.lane = F.tid & 63; F.wave = __builtin_amdgcn_readfirstlane(F.tid >> 6);
    F.G = gridDim.x; F.bid = blockIdx.x;
    F.ws = args.ws; F.ctl = (unsigned*)(args.ws + WS_CTL); F.in = args.in; F.out = args.out;
    for (int u = F.tid; u < (LDS_BYTES - MISC_OFF) / 4; u += NTHR) ((LAS unsigned*)(F.lds + MISC_OFF))[u] = 0u;
    __syncthreads();
    XcdBarrier bar; bar.bar = F.ctl + CW_BAR; bar.x = 0; bar.st = nullptr;
    if (MK_N_LAUNCHES == 1) bar = xcd_barrier_post(F.ctl + CW_BAR, F.MISC + 8);
    const int lo = args.ph_lo, hi = args.ph_hi;
    const int gw = F.bid * NWAVES + F.wave, NGW = F.G * NWAVES;
    LAS unsigned char* ring = F.lds;

    if (EN(0) && IN(0)) { PHASE_BEGIN();
        convert_layer_weights(F, 0, gw, NGW); convert_layer_weights(F, 1, gw, NGW); convert_ffn_weights(F, gw, NGW);
        rmsnorm_phase(F, F.in[0], F.in[1], WSP(bf16, WS_H));
        SEAM(0);
    }
#ifndef LMASK
#define LMASK 3
#endif
    if (LMASK & 1) layer_phases<0>(F, bar, lo, hi);
    if (LMASK & 2) layer_phases<1>(F, bar, lo, hi);
    if (EN(13) && IN(N_PHASES - 1)) final_phase(F, WSP(float, WS_XC), WSP(bf16, WS_YBUF), F.in[30], F.out);
#undef IN
#undef SEAM
}

extern "C" void kernel_launch(void* const* d_in, const int* in_sizes, int n_in, void* d_out, int out_size, void* d_ws, size_t ws_size, hipStream_t stream) {
    static int grid = 0;
    if (grid == 0) {
        if (n_in != 31 || in_sizes[0] != L * D || out_size != L * D || ws_size < WS_END) { fprintf(stderr, "kernel_launch: unexpected problem (n_in %d, out %d, ws %zu); nothing launched\n", n_in, out_size, ws_size); grid = -1; return; }
        int dev = 0, cus = 0, per_cu = 0;
        if (hipGetDevice(&dev) != hipSuccess || hipDeviceGetAttribute(&cus, hipDeviceAttributeMultiprocessorCount, dev) != hipSuccess) { grid = -1; return; }
        if (hipFuncSetAttribute((const void*)fwd_kernel, hipFuncAttributeMaxDynamicSharedMemorySize, LDS_BYTES) != hipSuccess) { fprintf(stderr, "kernel_launch: hipFuncSetAttribute failed\n"); grid = -1; return; }
        if (hipOccupancyMaxActiveBlocksPerMultiprocessor(&per_cu, (const void*)fwd_kernel, NTHR, LDS_BYTES) != hipSuccess || per_cu < 1) { fprintf(stderr, "kernel_launch: occupancy query reports %d workgroups per CU\n", per_cu); (void)hipGetLastError(); grid = -1; return; }
        if (cus != 256) { fprintf(stderr, "kernel_launch: built for 256 CUs, found %d\n", cus); grid = -1; return; }
        grid = 256;
    }
    if (grid < 0) return;
    if (hipMemsetAsync((char*)d_ws + WS_CTL, 0, CTL_ZERO_BYTES, stream) != hipSuccess) return;
    Args a{};
    for (int i = 0; i < 31; ++i) a.in[i] = (const float*)d_in[i];
    a.out = (float*)d_out; a.ws = (unsigned char*)d_ws;
    if (MK_N_LAUNCHES == 1) { a.ph_lo = 0; a.ph_hi = N_PHASES; hipLaunchKernelGGL(fwd_kernel, dim3(grid), dim3(NTHR), LDS_BYTES, stream, a); }
    else for (int p = 0; p < N_PHASES; ++p) {
        if (p == 1 || p == 1 + 9) continue;
        a.ph_lo = p; a.ph_hi = p + 1; hipLaunchKernelGGL(fwd_kernel, dim3(grid), dim3(NTHR), LDS_BYTES, stream, a);
    }
}
```

```cpp
#define MK_N_LAUNCHES 1

#include <hip/hip_runtime.h>
#include <cstdio>
#include <cstdint>

#ifndef MK_N_LAUNCHES
#define MK_N_LAUNCHES 1
#endif

#define LAS __attribute__((address_space(3)))
#define GAS __attribute__((address_space(1)))
typedef unsigned short bf16;
typedef short bf16x8 __attribute__((ext_vector_type(8)));
typedef float f32x4 __attribute__((ext_vector_type(4)));
typedef float f32x2 __attribute__((ext_vector_type(2)));
typedef unsigned u32x4 __attribute__((ext_vector_type(4)));
typedef unsigned u32x2 __attribute__((ext_vector_type(2)));
#define RLX_AGENT __ATOMIC_RELAXED, __HIP_MEMORY_SCOPE_AGENT
#define LDS_WAIT() asm volatile("s_waitcnt lgkmcnt(0)" ::: "memory")
#define VM_WAIT() asm volatile("s_waitcnt vmcnt(0)" ::: "memory")

constexpr int L = 16384, D = 1024, NWAVES = 8, NTHR = 512;
constexpr int PW = 6144;
constexpr int GW = 4096;
constexpr int YW = 2560;
constexpr int DFF = 2816, DFE = 3584, NE = 8;
constexpr int MAXSLOT = 34816;
constexpr float EPS = 1e-6f;

constexpr size_t MiB = 1u << 20;
constexpr size_t WS_CTL = 0, CTL_ZERO_BYTES = 1 * MiB;
constexpr size_t WS_SMALL = 1 * MiB;
constexpr size_t SM_GMW = 0, SM_POOLT = 256 * 1024, SM_WDT = 512 * 1024;
constexpr size_t WS_W1T = 2 * MiB;
constexpr size_t WS_BRT = 42 * MiB;
constexpr size_t WS_OUTT = 52 * MiB;
constexpr size_t WS_UPT = 56 * MiB;
constexpr size_t WS_DNT = 67 * MiB;
constexpr size_t WS_MOEDN = 2 * MiB;
constexpr size_t WS_XC = 74 * MiB;
constexpr size_t WS_R = 138 * MiB;
constexpr size_t WS_H = WS_R;
constexpr size_t WS_PROJ = WS_R + 32 * MiB;
constexpr size_t WS_YCAT = WS_R + 224 * MiB;
constexpr size_t WS_STATES = WS_R + 304 * MiB;
constexpr size_t WS_DACS = WS_R + 368 * MiB;
constexpr size_t WS_CC = WS_R + 369 * MiB;
constexpr size_t WS_GATES = WS_R + 32 * MiB;
constexpr size_t WS_MERGED = WS_R + 160 * MiB;
constexpr size_t WS_H2 = WS_R;
constexpr size_t WS_ACT = WS_R + 32 * MiB;
constexpr size_t WS_MOEUP = WS_R + 32 * MiB;
constexpr size_t WS_ROUTE = WS_R + 144 * MiB;
constexpr size_t RT_TOPK = 0, RT_CNT = 256 * 1024, RT_ROWIDX = 288 * 1024, RT_TOKSLOT = 448 * 1024, RT_TILEE = 640 * 1024, RT_NT = 644 * 1024;
constexpr size_t WS_ACTM = WS_R + 164 * MiB;
constexpr size_t WS_YBUF = WS_R + 32 * MiB;
constexpr size_t WS_END = 540 * MiB;
static_assert(WS_ACTM + (size_t)MAXSLOT * DFE <= WS_END, "ws map");
static_assert(WS_CC + (size_t)L * 512 * 2 <= WS_END, "ws map");
constexpr int CW_TMO = 0, CW_BAR = 4096;

constexpr int LDS_BYTES = 147456;
constexpr int MISC_OFF = LDS_BYTES - 256;
constexpr int WORK_BYTES = MISC_OFF;

typedef __bf16 bf16x2_t __attribute__((ext_vector_type(2)));
__device__ __forceinline__ unsigned cvt_pk_bf16(float lo, float hi) { const f32x2 v = {lo, hi}; const bf16x2_t r = __builtin_convertvector(v, bf16x2_t); return __builtin_bit_cast(unsigned, r); }
__device__ __forceinline__ unsigned cvt4_fp8(float a, float b, float c, float d) { unsigned r = 0; r = __builtin_amdgcn_cvt_pk_fp8_f32(a, b, r, false); r = __builtin_amdgcn_cvt_pk_fp8_f32(c, d, r, true); return r; }
constexpr float MOE_UP_WSCALE = 32.f, MOE_DN_WSCALE = 64.f;
__device__ __forceinline__ float bflo(unsigned u) { return __uint_as_float(u << 16); }
__device__ __forceinline__ float bfhi(unsigned u) { return __uint_as_float(u & 0xffff0000u); }
__device__ __forceinline__ float bf1(bf16 b) { return __uint_as_float(((unsigned)b) << 16); }
__device__ __forceinline__ bf16 f2bf(float f) { return (bf16)(cvt_pk_bf16(f, 0.f) & 0xffffu); }
__device__ __forceinline__ void unpack8(const u32x4 v, float (&o)[8]) { o[0] = bflo(v.x); o[1] = bfhi(v.x); o[2] = bflo(v.y); o[3] = bfhi(v.y); o[4] = bflo(v.z); o[5] = bfhi(v.z); o[6] = bflo(v.w); o[7] = bfhi(v.w); }
__device__ __forceinline__ u32x4 pack8(const float (&o)[8]) { u32x4 v; v.x = cvt_pk_bf16(o[0], o[1]); v.y = cvt_pk_bf16(o[2], o[3]); v.z = cvt_pk_bf16(o[4], o[5]); v.w = cvt_pk_bf16(o[6], o[7]); return v; }
__device__ __forceinline__ float fast_exp(float x) { return __builtin_amdgcn_exp2f(x * 1.4426950408889634f); }
__device__ __forceinline__ float fast_rcp(float x) { return __builtin_amdgcn_rcpf(x); }
__device__ __forceinline__ float sigmoid_f(float x) { return fast_rcp(1.f + fast_exp(-x)); }
__device__ __forceinline__ float silu_f(float x) { return x * sigmoid_f(x); }
__device__ __forceinline__ float gelu_tanh_f(float x) { const float u = 0.7978845608028654f * (x + 0.044715f * x * x * x); return x * sigmoid_f(2.f * u); }
__device__ __forceinline__ float softplus_f(float x) { return fmaxf(x, 0.f) + log1pf(expf(-fabsf(x))); }
__device__ __forceinline__ float wave_sum(float v) {
#pragma unroll
    for (int o = 1; o < 64; o <<= 1) v += __shfl_xor(v, o);
    return v;
}
#define MMA16(acc, q, p) (acc) = __builtin_amdgcn_mfma_f32_16x16x32_bf16((q), (p), (acc), 0, 0, 0)
__device__ __forceinline__ bf16x8 ldsfrag(LAS unsigned char* base, int byteoff) { return *(const LAS bf16x8*)(base + byteoff); }
__device__ __forceinline__ bf16x8 gfrag(const bf16* p) { return *(const bf16x8*)p; }

#define XB_TMO      128
#define XB_XCNT(j)  (256  + 64 * (j))
#define XB_XSUB(j)  (1280 + 64 * (j))
#define XB_XGEN(j)  (2304 + 64 * (j))
#define XB_TOP      3328
#define XB_TOPGEN   3392
#define XCD_BAR_WORDS 3456
#define XB_SPIN_CAP (1u << 18)
__device__ __forceinline__ unsigned xb_ld(unsigned* p)              { return __hip_atomic_load(p, __ATOMIC_RELAXED, __HIP_MEMORY_SCOPE_AGENT); }
__device__ __forceinline__ unsigned xb_add(unsigned* p, unsigned v) { return __hip_atomic_fetch_add(p, v, __ATOMIC_RELAXED, __HIP_MEMORY_SCOPE_AGENT); }
__device__ __forceinline__ unsigned xb_xcc_id() { return (unsigned)__builtin_amdgcn_s_getreg((3 << 11) | 20) & 0xFu; }
#define XB_SPIN(cond, bar) do { unsigned _sp = 0; while (cond) { __builtin_amdgcn_s_sleep(1); \
    if ((++_sp & 255u) == 0u) { if (xb_ld(&(bar)[XB_TMO])) break; if (_sp > XB_SPIN_CAP) { atomicAdd(&(bar)[XB_TMO], 1u); break; } } } } while (0)
struct XcdBarrier { unsigned* bar; unsigned x; volatile LAS unsigned* st; };
__device__ __forceinline__ XcdBarrier xcd_barrier_post(unsigned* bar, volatile LAS unsigned* st) {
    XcdBarrier b; b.bar = bar; b.x = xb_xcc_id(); b.st = st;
    if (threadIdx.x == 0) (void)xb_add(&bar[XB_XCNT(b.x)], 1u);
    return b;
}
__device__ __forceinline__ void xcd_barrier_complete(unsigned* bar, unsigned x, unsigned& nloc, unsigned& nx) {
    const unsigned G = gridDim.x * gridDim.y * gridDim.z;
    unsigned sum, cnt, mine, sp = 0u;
    for (;;) {
        sum = 0u; cnt = 0u; mine = 0u;
#pragma unroll
        for (unsigned j = 0; j < 16; ++j) { const unsigned c = xb_ld(&bar[XB_XCNT(j)]); sum += c; cnt += (c > 0u) ? 1u : 0u; mine = (j == x) ? c : mine; }
        if (sum == G) break;
        __builtin_amdgcn_s_sleep(1);
        if ((++sp & 255u) == 0u) { if (xb_ld(&bar[XB_TMO])) break; if (sp > XB_SPIN_CAP) { atomicAdd(&bar[XB_TMO], 1u); break; } }
    }
    nloc = mine > 0u ? mine : 1u; nx = cnt > 0u ? cnt : 1u;
}
__device__ __forceinline__ void xcd_barrier(const XcdBarrier& b) {
    asm volatile("s_waitcnt vmcnt(0)" ::: "memory");
    __syncthreads();
    if (threadIdx.x == 0) {
        unsigned* bar = b.bar;
        __builtin_amdgcn_s_waitcnt(0);
        unsigned nloc = b.st[0], nx = b.st[1];
        if (nloc == 0u) { xcd_barrier_complete(bar, b.x, nloc, nx); b.st[0] = nloc; b.st[1] = nx; }
        const unsigned old = xb_add(&bar[XB_XSUB(b.x)], 1u);
        const unsigned gen = old / nloc;
        if (old + 1u == (gen + 1u) * nloc) {
            __builtin_amdgcn_fence(__ATOMIC_RELEASE, "agent");
            asm volatile("s_waitcnt vmcnt(0)" ::: "memory");
            const unsigned og = xb_add(&bar[XB_TOP], 1u);
            const unsigned tg = og / nx;
            if (og + 1u == (tg + 1u) * nx) xb_add(&bar[XB_TOPGEN], 1u);
            else XB_SPIN(xb_ld(&bar[XB_TOPGEN]) == tg, bar);
            __builtin_amdgcn_fence(__ATOMIC_ACQUIRE, "agent");
            xb_add(&bar[XB_XGEN(b.x)], 1u);
            asm volatile("s_waitcnt vmcnt(0)" ::: "memory");
        } else {
            XB_SPIN(xb_ld(&bar[XB_XGEN(b.x)]) == gen, bar);
            __builtin_amdgcn_fence(__ATOMIC_ACQUIRE, "agent");
            asm volatile("s_waitcnt vmcnt(0)" ::: "memory");
        }
    }
    __syncthreads();
}
namespace pg8 {
constexpr int BM = 256, BK = 64, HALF = 128, HTB = HALF * BK * 2, STAGE_BYTES = 8 * HTB, NXCD = 8, WGM = 8;
__host__ __device__ __forceinline__ int lds_byte(int r, int c) { const int st = (r >> 4) * 2 + (c >> 5), rr = r & 15, cc = c & 31, ob = rr * 64 + cc * 2; return st * 1024 + (ob ^ (((ob >> 9) & 1) << 5)); }
__host__ __device__ __forceinline__ void stage_rc(int b, int& R, int& C) { const int st = b / 1024, sb = b % 1024, swz = sb ^ (((sb >> 9) & 1) << 5); R = (st >> 1) * 16 + swz / 64; C = (st & 1) * 32 + (swz % 64) / 2; }
__host__ __device__ __forceinline__ int perm32(int rho) { const int n = rho >> 4, i = rho & 15; return 8 * (i >> 2) + 4 * n + (i & 3); }

struct Unit { int pm, pn; const char* a; const char* b; };
struct TileOrder {
    int nM, nN, nwg, G, c;
    __device__ __forceinline__ void init(int nM_, int nN_, int G_, int c_) { nM = nM_; nN = nN_; nwg = nM * nN; G = G_; c = c_; }
    __device__ __forceinline__ bool tile(int i, int& pm, int& pn) const {
        const long Lq = (long)i * G + c; if (Lq >= nwg) return false;
        int wgid = (int)Lq; { const int q = nwg / NXCD, r = nwg % NXCD, xcd = wgid % NXCD, off = wgid / NXCD; wgid = (xcd < r ? xcd * (q + 1) : r * (q + 1) + (xcd - r) * q) + off; }
        const int nig = WGM * nN, gid = wgid / nig, fm = gid * WGM, gsz = (nM - fm) < WGM ? (nM - fm) : WGM;
        pm = fm + ((wgid % nig) % gsz); pn = (wgid % nig) / gsz; return true;
    }
};
struct DenseSched {
    TileOrder o; const char* A; const char* Bt; size_t tstep;
    __device__ __forceinline__ void init(const bf16* A_, const bf16* Bt_, int M, int N, int K, int G, int c) { o.init(M / BM, N / BM, G, c); A = (const char*)A_; Bt = (const char*)Bt_; tstep = (size_t)BM * K * 2; }
    __device__ __forceinline__ bool next(int i, Unit& u) const { if (!o.tile(i, u.pm, u.pn)) return false; u.a = A + (size_t)u.pm * tstep; u.b = Bt + (size_t)u.pn * tstep; return true; }
    __device__ __forceinline__ unsigned arow(const Unit&, int) const { return 0u; }
};

__device__ __forceinline__ unsigned cvt_pk(float lo, float hi) { return cvt_pk_bf16(lo, hi); }

struct EpiBf16Act {
    static constexpr bool PERM = true, HAS_MID = false;
    bf16* O; int ldc; int gelu_lo, gelu_hi; int sig;
    __device__ __forceinline__ void operator()(f32x4 (&acc)[2][2][4][2], const Unit& u, int wr, int wc, int fr, int fq) const {
        asm volatile("" : "+v"(fr), "+v"(fq));
        const int row0 = u.pm * BM + wr * 64 + fr, col0 = u.pn * BM + wc * 32 + 8 * fq;
        const int mode = sig ? 2 : ((u.pn >= gelu_lo && u.pn < gelu_hi) ? 1 : 0);
#pragma unroll
        for (int ai = 0; ai < 2; ++ai)
#pragma unroll
            for (int m = 0; m < 4; ++m) { bf16* rowp = O + (size_t)(row0 + ai * HALF + m * 16) * ldc + col0;
#pragma unroll
                for (int bj = 0; bj < 2; ++bj) { f32x4 v0 = acc[ai][bj][m][0], v1 = acc[ai][bj][m][1];
                    if (mode == 1) {
#pragma unroll
                        for (int j = 0; j < 4; ++j) { v0[j] = gelu_tanh_f(v0[j]); v1[j] = gelu_tanh_f(v1[j]); } }
                    else if (mode == 2) {
#pragma unroll
                        for (int j = 0; j < 4; ++j) { v0[j] = sigmoid_f(v0[j]); v1[j] = sigmoid_f(v1[j]); } }
                    u32x4 w; w.x = cvt_pk(v0[0], v0[1]); w.y = cvt_pk(v0[2], v0[3]); w.z = cvt_pk(v1[0], v1[1]); w.w = cvt_pk(v1[2], v1[3]);
                    *(u32x4*)(rowp + bj * HALF) = w; } }
    }
};
struct EpiSwiglu {
    static constexpr bool PERM = true, HAS_MID = false;
    bf16* O; int ldc;
    __device__ __forceinline__ void operator()(f32x4 (&acc)[2][2][4][2], const Unit& u, int wr, int wc, int fr, int fq) const {
        asm volatile("" : "+v"(fr), "+v"(fq));
        const int row0 = u.pm * BM + wr * 64 + fr, col0 = u.pn * HALF + wc * 32 + 8 * fq;
#pragma unroll
        for (int ai = 0; ai < 2; ++ai)
#pragma unroll
            for (int m = 0; m < 4; ++m) { bf16* rowp = O + (size_t)(row0 + ai * HALF + m * 16) * ldc + col0;
                f32x4 v0, v1;
#pragma unroll
                for (int j = 0; j < 4; ++j) { v0[j] = silu_f(acc[ai][0][m][0][j]) * acc[ai][1][m][0][j]; v1[j] = silu_f(acc[ai][0][m][1][j]) * acc[ai][1][m][1][j]; }
                u32x4 w; w.x = cvt_pk(v0[0], v0[1]); w.y = cvt_pk(v0[2], v0[3]); w.z = cvt_pk(v1[0], v1[1]); w.w = cvt_pk(v1[2], v1[3]);
                *(u32x4*)rowp = w; }
    }
};
struct EpiSwigluF8 {
    static constexpr bool PERM = true, HAS_MID = false;
    unsigned char* O; int ldc; float descale;
    __device__ __forceinline__ void operator()(f32x4 (&acc)[2][2][4][2], const Unit& u, int wr, int wc, int fr, int fq) const {
        asm volatile("" : "+v"(fr), "+v"(fq));
        const int row0 = u.pm * BM + wr * 64 + fr, col0 = u.pn * HALF + wc * 32 + 8 * fq;
#pragma unroll
        for (int ai = 0; ai < 2; ++ai)
#pragma unroll
            for (int m = 0; m < 4; ++m) { unsigned char* rowp = O + (size_t)(row0 + ai * HALF + m * 16) * ldc + col0;
                f32x4 v0, v1;
#pragma unroll
                for (int j = 0; j < 4; ++j) { v0[j] = silu_f(acc[ai][0][m][0][j] * descale) * (acc[ai][1][m][0][j] * descale); v1[j] = silu_f(acc[ai][0][m][1][j] * descale) * (acc[ai][1][m][1][j] * descale); }
                u32x2 w; w.x = cvt4_fp8(v0[0], v0[1], v0[2], v0[3]); w.y = cvt4_fp8(v1[0], v1[1], v1[2], v1[3]);
                *(u32x2*)rowp = w; }
    }
};
struct EpiBf16Scale {
    static constexpr bool PERM = true, HAS_MID = false;
    bf16* O; int ldc; float descale;
    __device__ __forceinline__ void operator()(f32x4 (&acc)[2][2][4][2], const Unit& u, int wr, int wc, int fr, int fq) const {
        asm volatile("" : "+v"(fr), "+v"(fq));
        const int row0 = u.pm * BM + wr * 64 + fr, col0 = u.pn * BM + wc * 32 + 8 * fq;
#pragma unroll
        for (int ai = 0; ai < 2; ++ai)
#pragma unroll
            for (int m = 0; m < 4; ++m) { bf16* rowp = O + (size_t)(row0 + ai * HALF + m * 16) * ldc + col0;
#pragma unroll
                for (int bj = 0; bj < 2; ++bj) { const f32x4 v0 = acc[ai][bj][m][0] * descale, v1 = acc[ai][bj][m][1] * descale;
                    u32x4 w; w.x = cvt_pk(v0[0], v0[1]); w.y = cvt_pk(v0[2], v0[3]); w.z = cvt_pk(v1[0], v1[1]); w.w = cvt_pk(v1[2], v1[3]);
                    *(u32x4*)(rowp + bj * HALF) = w; } }
    }
};
struct EpiResid {
    static constexpr bool PERM = false, HAS_MID = false;
    const float* R; float* O; int ldc;
    __device__ __forceinline__ void operator()(f32x4 (&acc)[2][2][4][2], const Unit& u, int wr, int wc, int fr, int fq) const {
        asm volatile("" : "+v"(fr), "+v"(fq));
        const int row0 = u.pm * BM + wr * 64 + fr, col0 = u.pn * BM + wc * 32 + 4 * fq;
#pragma unroll
        for (int ai = 0; ai < 2; ++ai)
#pragma unroll
            for (int m = 0; m < 4; ++m) { const size_t off = (size_t)(row0 + ai * HALF + m * 16) * ldc + col0;
#pragma unroll
                for (int bj = 0; bj < 2; ++bj)
#pragma unroll
                    for (int n = 0; n < 2; ++n) { const f32x4 r = *(const f32x4*)(R + off + bj * HALF + n * 16); *(f32x4*)(O + off + bj * HALF + n * 16) = r + acc[ai][bj][m][n]; }
                asm volatile("" ::: "memory"); }
    }
};
struct EpiMerge {
    static constexpr bool PERM = true, HAS_MID = true;
    const bf16* Gt; bf16* O;
    __device__ __forceinline__ int mid_branch(int kdone) const { return kdone == 512 ? 1 : (kdone == 1536 ? 2 : (kdone == 2048 ? 3 : 0)); }
    __device__ __forceinline__ void mid(f32x4 (&acc)[2][2][4][2], const Unit& u, int nb, int wr, int wc, int fr, int fq) const {
        asm volatile("" : "+v"(fr), "+v"(fq));
        const int row0 = u.pm * BM + wr * 64 + fr, col0 = u.pn * BM + wc * 32 + 8 * fq;
#pragma unroll
        for (int ai = 0; ai < 2; ++ai)
#pragma unroll
            for (int m = 0; m < 4; ++m) { const unsigned go = (unsigned)(row0 + ai * HALF + m * 16) * (unsigned)GW + (unsigned)col0 + (unsigned)(nb - 1) * 1024u;
#pragma unroll
                for (int bj = 0; bj < 2; ++bj) { const u32x4 a = *(const u32x4*)(Gt + (go + bj * HALF)), b = *(const u32x4*)(Gt + (go + 1024u + bj * HALF));
                    float ga[8], gb[8]; unpack8(a, ga); unpack8(b, gb);
#pragma unroll
                    for (int j = 0; j < 4; ++j) { acc[ai][bj][m][0][j] *= ga[j] * fast_rcp(gb[j]); acc[ai][bj][m][1][j] *= ga[4 + j] * fast_rcp(gb[4 + j]); }
                    asm volatile("" : "+v"(acc[ai][bj][m][0]), "+v"(acc[ai][bj][m][1]) :: "memory"); } }
    }
    __device__ __forceinline__ void operator()(f32x4 (&acc)[2][2][4][2], const Unit& u, int wr, int wc, int fr, int fq) const {
        asm volatile("" : "+v"(fr), "+v"(fq));
        const int row0 = u.pm * BM + wr * 64 + fr, col0 = u.pn * BM + wc * 32 + 8 * fq;
#pragma unroll
        for (int ai = 0; ai < 2; ++ai)
#pragma unroll
            for (int m = 0; m < 4; ++m) { const unsigned r = (unsigned)(row0 + ai * HALF + m * 16);
#pragma unroll
                for (int bj = 0; bj < 2; ++bj) { const u32x4 g3 = *(const u32x4*)(Gt + (r * (unsigned)GW + 3072u + (unsigned)col0 + bj * HALF)); float g[8]; unpack8(g3, g);
                    const f32x4 v0 = acc[ai][bj][m][0], v1 = acc[ai][bj][m][1];
                    u32x4 w; w.x = cvt_pk(v0[0] * g[0], v0[1] * g[1]); w.y = cvt_pk(v0[2] * g[2], v0[3] * g[3]); w.z = cvt_pk(v1[0] * g[4], v1[1] * g[5]); w.w = cvt_pk(v1[2] * g[6], v1[3] * g[7]);
                    *(u32x4*)(O + (r * (unsigned)D + (unsigned)col0 + bj * HALF)) = w; }
                asm volatile("" ::: "memory"); }
    }
};

typedef int v8i __attribute__((ext_vector_type(8)));
typedef int u32x4i __attribute__((ext_vector_type(4)));
template <class Epi, class Sched, bool ALIGN_EPI, bool GATHER, int ESZ = 2>
__device__ __forceinline__ void gemm_phase(LAS unsigned char* lds, const int Kelem, const Sched& S, const Epi& E) {
    const int K = (ESZ == 2) ? Kelem : (Kelem >> 1);
    int tid_ = threadIdx.x; asm volatile("" : "+v"(tid_)); const int tid = tid_, wid = __builtin_amdgcn_readfirstlane(tid >> 6), lane = tid & 63, wr = wid >> 2, wc = wid & 3, fr = lane & 15, fq = lane >> 4;
    const int nt = K / BK;
    unsigned voffB[2], aoC[2][2], aoN[2][2];
#pragma unroll
    for (int i = 0; i < 2; ++i) { int R, C; stage_rc(tid * 16 + i * 8192, R, C); const int Rb = Epi::PERM ? ((R & ~31) + perm32(R & 31)) : R;
        voffB[i] = (unsigned)(Rb * K + C) * 2u;
#pragma unroll
        for (int h = 0; h < 2; ++h) { aoC[h][i] = (unsigned)((R + h * HALF) * K + C) * 2u; aoN[h][i] = aoC[h][i]; } }
    const size_t kstep = (size_t)(BK * 2);
    const size_t hstep = (size_t)HALF * K * 2;
    const size_t pstep = (size_t)64 * K * 2;
    const unsigned ldsw = (unsigned)wid * 1024u;
    const int aoff = lds_byte(wr * 64 + fr, fq * 8), boff = lds_byte(wc * 32 + fr, fq * 8);
#define PG8_SA(b, h) (((b) * 2 + (h)) * HTB)
#define PG8_SB(b, h) ((4 + (b) * 2 + (h)) * HTB)
#define PG8_STAGE(bufoff, gbase, voff) do { const char* _sb = (const char*)(gbase); asm volatile("" : "+s"(_sb)); _Pragma("unroll") for (int _i = 0; _i < 2; ++_i) \
        __builtin_amdgcn_global_load_lds((const unsigned*)(_sb + (voff)[_i]), (LAS unsigned*)(lds + (bufoff) + ldsw + _i * 8192), 16, 0, 0); } while (0)
#define PG8_STAGE1(bufoff, gbase, voff0) do { _Pragma("unroll") for (int _i = 0; _i < 2; ++_i) { const char* _sb = (const char*)(gbase) + (size_t)_i * pstep; asm volatile("" : "+s"(_sb)); \
        __builtin_amdgcn_global_load_lds((const unsigned*)(_sb + (voff0)), (LAS unsigned*)(lds + (bufoff) + ldsw + _i * 8192), 16, 0, 0); } } while (0)
#define PG8_STAGE_AC(bufoff, gbase, h) do { if constexpr (GATHER) PG8_STAGE(bufoff, gbase, aoC[h]); else PG8_STAGE1(bufoff, (const char*)(gbase) + (size_t)(h) * hstep, aoC[0][0]); } while (0)
#define PG8_STAGE_A2(bufoff, gbase, h) do { if constexpr (GATHER) { if (last) PG8_STAGE(bufoff, gbase, aoN[h]); else PG8_STAGE(bufoff, gbase, aoC[h]); } else PG8_STAGE1(bufoff, (const char*)(gbase) + (size_t)(h) * hstep, aoC[0][0]); } while (0)
#define PG8_LDA(dst, b, h) do { _Pragma("unroll") for (int m = 0; m < 4; ++m) _Pragma("unroll") for (int k = 0; k < 2; ++k) dst[m][k] = *(const LAS bf16x8*)(lds + PG8_SA(b, h) + aoff + m * 2048 + k * 1024); } while (0)
#define PG8_LDB(dst, b, h) do { _Pragma("unroll") for (int n = 0; n < 2; ++n) _Pragma("unroll") for (int k = 0; k < 2; ++k) dst[n][k] = *(const LAS bf16x8*)(lds + PG8_SB(b, h) + boff + n * 2048 + k * 1024); } while (0)
#define PG8_MMA(ai, bj, At, Bt) do { __builtin_amdgcn_s_setprio(1); _Pragma("unroll") for (int m = 0; m < 4; ++m) _Pragma("unroll") for (int n = 0; n < 2; ++n) _Pragma("unroll") for (int k = 0; k < 2; ++k) \
        acc[ai][bj][m][n] = __builtin_amdgcn_mfma_f32_16x16x32_bf16(Bt[n][k], At[m][k], acc[ai][bj][m][n], 0, 0, 0); __builtin_amdgcn_s_setprio(0); } while (0)
#define PG8_MMA8(ai, bj, A8, B8) do { __builtin_amdgcn_s_setprio(1); _Pragma("unroll") for (int m = 0; m < 4; ++m) _Pragma("unroll") for (int n = 0; n < 2; ++n) \
        acc[ai][bj][m][n] = __builtin_amdgcn_mfma_scale_f32_16x16x128_f8f6f4(B8[n], A8[m], acc[ai][bj][m][n], 0, 0, 0, one_scale, 0, one_scale); \
        asm volatile("" : "+v"(acc[ai][bj][0][0]), "+v"(acc[ai][bj][0][1]), "+v"(acc[ai][bj][1][0]), "+v"(acc[ai][bj][1][1]), "+v"(acc[ai][bj][2][0]), "+v"(acc[ai][bj][2][1]), "+v"(acc[ai][bj][3][0]), "+v"(acc[ai][bj][3][1])); \
        __builtin_amdgcn_s_setprio(0); } while (0)
#define PG8_LDA8(dst, b, h) do { _Pragma("unroll") for (int m = 0; m < 4; ++m) dst[m] = __builtin_shufflevector(*(const LAS u32x4i*)(lds + PG8_SA(b, h) + aoff + m * 2048), *(const LAS u32x4i*)(lds + PG8_SA(b, h) + aoff + m * 2048 + 1024), 0, 1, 2, 3, 4, 5, 6, 7); } while (0)
#define PG8_LDB8(dst, b, h) do { _Pragma("unroll") for (int n = 0; n < 2; ++n) dst[n] = __builtin_shufflevector(*(const LAS u32x4i*)(lds + PG8_SB(b, h) + boff + n * 2048), *(const LAS u32x4i*)(lds + PG8_SB(b, h) + boff + n * 2048 + 1024), 0, 1, 2, 3, 4, 5, 6, 7); } while (0)
#define PG8_MM(ai, bj, At, Bt) do { if constexpr (ESZ == 2) PG8_MMA(ai, bj, At, Bt); else PG8_MMA8(ai, bj, At##8, Bt##8); } while (0)
#define PG8_LA(dst, b, h) do { if constexpr (ESZ == 2) PG8_LDA(dst, b, h); else PG8_LDA8(dst##8, b, h); } while (0)
#define PG8_LB(dst, b, h) do { if constexpr (ESZ == 2) PG8_LDB(dst, b, h); else PG8_LDB8(dst##8, b, h); } while (0)
#define PG8_WAIT_V(n) asm volatile("s_waitcnt vmcnt(" #n ")" ::: "memory")
#define PG8_WAIT_L(n) asm volatile("s_waitcnt lgkmcnt(" #n ")" ::: "memory")
#define PG8_BAR __builtin_amdgcn_s_barrier()
#define PG8_SCHED __builtin_amdgcn_sched_barrier(0)
    int one_scale = 0x7f7f7f7f; asm volatile("" : "+v"(one_scale));
    Unit cur, nxt; int ui = 0;
    if (!S.next(0, cur)) return;
    if constexpr (GATHER) {
#pragma unroll
        for (int h = 0; h < 2; ++h)
#pragma unroll
            for (int i = 0; i < 2; ++i) { int R, C; stage_rc(tid * 16 + i * 8192, R, C); aoC[h][i] = (S.arow(cur, h * HALF + R) * (unsigned)K + (unsigned)C) * 2u; }
    }
    f32x4 acc[2][2][4][2];
#pragma unroll
    for (int a = 0; a < 2; ++a)
#pragma unroll
        for (int b = 0; b < 2; ++b)
#pragma unroll
            for (int m = 0; m < 4; ++m)
#pragma unroll
                for (int n = 0; n < 2; ++n) acc[a][b][m][n] = (f32x4){0.f, 0.f, 0.f, 0.f};
    bf16x8 At[4][2], B0[2][2], B1[2][2]; v8i At8[4], B08[2], B18[2];
    const char* cA = cur.a; const char* cB = cur.b;
    PG8_STAGE1(PG8_SB(0, 0), cB, voffB[0]); PG8_STAGE1(PG8_SB(0, 1), cB + hstep, voffB[0]); PG8_STAGE_AC(PG8_SA(0, 0), cA, 0); PG8_STAGE_AC(PG8_SA(0, 1), cA, 1);
    if (wr == 1) PG8_BAR;
    PG8_WAIT_V(2); PG8_BAR;
    PG8_STAGE1(PG8_SB(1, 0), cB + kstep, voffB[0]); PG8_STAGE_AC(PG8_SA(1, 0), cA + kstep, 0); PG8_STAGE1(PG8_SB(1, 1), cB + hstep + kstep, voffB[0]);
    PG8_WAIT_V(6); PG8_BAR;
    for (;;) {
        const bool has_next = S.next(ui + 1, nxt);
        const char* nA = has_next ? nxt.a : cA; const char* nB = has_next ? nxt.b : cB;
        if constexpr (GATHER) {
#pragma unroll
            for (int h = 0; h < 2; ++h)
#pragma unroll
                for (int i = 0; i < 2; ++i) { int R, C; stage_rc(tid * 16 + i * 8192, R, C); aoN[h][i] = has_next ? (S.arow(nxt, h * HALF + R) * (unsigned)K + (unsigned)C) * 2u : aoC[h][i]; }
        }
        for (int t = 0; t < nt; t += 2) {
            const bool last = (t == nt - 2);
            const char* a1 = cA + (size_t)(t + 1) * kstep;
            const char* a2 = last ? nA : cA + (size_t)(t + 2) * kstep; const char* b2 = last ? nB : cB + (size_t)(t + 2) * kstep;
            const char* a3 = a2 + kstep; const char* b3 = b2 + kstep;
            PG8_LB(B0, 0, 0); PG8_LB(B1, 0, 1); PG8_SCHED; PG8_LA(At, 0, 0); PG8_STAGE_AC(PG8_SA(1, 1), a1, 1);
            PG8_WAIT_V(8); PG8_WAIT_L(0); PG8_BAR; PG8_MM(0, 0, At, B0); PG8_MM(0, 1, At, B1); PG8_BAR; PG8_SCHED;
            PG8_LA(At, 0, 1); PG8_STAGE1(PG8_SB(0, 0), b2, voffB[0]); PG8_STAGE1(PG8_SB(0, 1), b2 + hstep, voffB[0]); PG8_STAGE_A2(PG8_SA(0, 0), a2, 0);
            PG8_WAIT_V(8); PG8_WAIT_L(0); PG8_BAR; PG8_MM(1, 0, At, B0); PG8_MM(1, 1, At, B1); PG8_BAR; PG8_SCHED;
            PG8_LB(B0, 1, 0); PG8_LB(B1, 1, 1); PG8_SCHED; PG8_LA(At, 1, 0); PG8_STAGE_A2(PG8_SA(0, 1), a2, 1);
            PG8_WAIT_V(8); PG8_WAIT_L(0); PG8_BAR; PG8_MM(0, 0, At, B0); PG8_MM(0, 1, At, B1); PG8_BAR; PG8_SCHED;
            PG8_LA(At, 1, 1); PG8_STAGE1(PG8_SB(1, 0), b3, voffB[0]); PG8_STAGE1(PG8_SB(1, 1), b3 + hstep, voffB[0]); PG8_STAGE_A2(PG8_SA(1, 0), a3, 0);
            PG8_WAIT_V(8); PG8_WAIT_L(0); PG8_BAR; PG8_MM(1, 0, At, B0); PG8_MM(1, 1, At, B1); PG8_BAR; PG8_SCHED;
            if constexpr (Epi::HAS_MID) { const int nb = E.mid_branch((t + 2) * BK); if (nb) { PG8_SCHED; E.mid(acc, cur, nb, wr, wc, fr, fq); PG8_SCHED; } }
        }
        if constexpr (ALIGN_EPI) { if (wr == 0) PG8_BAR; }
        E(acc, cur, wr, wc, fr, fq);
        if (!has_next) break;
#pragma unroll
        for (int a = 0; a < 2; ++a)
#pragma unroll
            for (int b = 0; b < 2; ++b)
#pragma unroll
                for (int m = 0; m < 4; ++m)
#pragma unroll
                    for (int n = 0; n < 2; ++n) acc[a][b][m][n] = (f32x4){0.f, 0.f, 0.f, 0.f};
        cur = nxt; cA = nA; cB = nB; ++ui;
        if constexpr (GATHER) {
#pragma unroll
            for (int h = 0; h < 2; ++h)
#pragma unroll
                for (int i = 0; i < 2; ++i) aoC[h][i] = aoN[h][i];
        }
        if constexpr (ALIGN_EPI) { if (wr == 1) PG8_BAR; }
    }
    PG8_WAIT_V(0);
    if constexpr (!ALIGN_EPI) { if (wr == 0) PG8_BAR; }
    PG8_BAR;
#undef PG8_SA
#undef PG8_SB
#undef PG8_STAGE
#undef PG8_STAGE1
#undef PG8_STAGE_A2
#undef PG8_STAGE_AC
#undef PG8_LDA
#undef PG8_LDB
#undef PG8_MMA
#undef PG8_MMA8
#undef PG8_MM
#undef PG8_LDA8
#undef PG8_LDB8
#undef PG8_LA
#undef PG8_LB
#undef PG8_WAIT_V
#undef PG8_WAIT_L
#undef PG8_BAR
#undef PG8_SCHED
}
}
struct Frame {
    LAS unsigned char* lds;
    volatile LAS unsigned* MISC;
    unsigned* ctl;
    unsigned char* ws;
    const float* const* in;
    float* out;
    int tid, lane, wave, G, bid;
};
#define WSP(T, off) ((T*)(F.ws + (off)))

__device__ __forceinline__ void tr_item(const float* src, int ldsrc, bf16* dst, int ldd, LAS float* scr, int lane) {
#pragma unroll 8
    for (int i = 0; i < 32; ++i) { const int kk = 2 * i + (lane >> 5); scr[kk * 33 + (lane & 31)] = src[(size_t)kk * ldsrc + (lane & 31)]; }
    LDS_WAIT(); asm volatile("" ::: "memory");
    const int c = lane & 7;
#pragma unroll
    for (int j = 0; j < 4; ++j) { const int n = (lane >> 3) + 8 * j; const LAS float* s = scr + (8 * c) * 33 + n;
        u32x4 o; o.x = cvt_pk_bf16(s[0 * 33], s[1 * 33]); o.y = cvt_pk_bf16(s[2 * 33], s[3 * 33]); o.z = cvt_pk_bf16(s[4 * 33], s[5 * 33]); o.w = cvt_pk_bf16(s[6 * 33], s[7 * 33]);
        *(u32x4*)(dst + (size_t)n * ldd + 8 * c) = o; }
    LDS_WAIT(); asm volatile("" ::: "memory");
}
__device__ __forceinline__ void tr_item_f8(const float* src, int ldsrc, unsigned char* dst, int ldd, float scale, LAS float* scr, int lane) {
#pragma unroll 8
    for (int i = 0; i < 64; ++i) { const int kk = 2 * i + (lane >> 5); scr[kk * 33 + (lane & 31)] = src[(size_t)kk * ldsrc + (lane & 31)] * scale; }
    LDS_WAIT(); asm volatile("" ::: "memory");
    const int c = lane & 7;
#pragma unroll
    for (int j = 0; j < 4; ++j) { const int n = (lane >> 3) + 8 * j; const LAS float* s = scr + (16 * c) * 33 + n;
        u32x4 o; o.x = cvt4_fp8(s[0 * 33], s[1 * 33], s[2 * 33], s[3 * 33]); o.y = cvt4_fp8(s[4 * 33], s[5 * 33], s[6 * 33], s[7 * 33]);
        o.z = cvt4_fp8(s[8 * 33], s[9 * 33], s[10 * 33], s[11 * 33]); o.w = cvt4_fp8(s[12 * 33], s[13 * 33], s[14 * 33], s[15 * 33]);
        *(u32x4*)(dst + (size_t)n * ldd + 16 * c) = o; }
    LDS_WAIT(); asm volatile("" ::: "memory");
}
__device__ __forceinline__ void tr_job_item(const float* src, int ldsrc, int sc0, int K, int N, bf16* dst, int ldd, int dr0, int dk0, int it, LAS float* scr, int lane) {
    const int nblk = N / 32, kb = it / nblk, nb = it % nblk;
    tr_item(src + (size_t)(64 * kb) * ldsrc + sc0 + 32 * nb, ldsrc, dst + (size_t)(dr0 + 32 * nb) * ldd + dk0 + 64 * kb, ldd, scr, lane);
}
__device__ __forceinline__ void tr_up_item(const float* wg, const float* wu, int FF, bf16* dst, int it, LAS float* scr, int lane) {
    const int nblk = 2 * FF / 32, kb = it / nblk, nb = it % nblk, r0 = 32 * nb, pn = r0 >> 8, s = (r0 >> 7) & 1, j = r0 & 127;
    const float* src = (s ? wu : wg) + (size_t)(64 * kb) * FF + 128 * pn + j;
    tr_item(src, FF, dst + (size_t)r0 * D + 64 * kb, D, scr, lane);
}
__device__ __forceinline__ void convert_layer_weights(Frame& F, int l, int gw, int NGW) {
    LAS float* scr = (LAS float*)(F.lds + F.wave * 8448);
    const float* w_in = F.in[2] + (size_t)l * D * 6160; const float* w_gate = F.in[3] + (size_t)l * D * 4096;
    bf16* W1T = WSP(bf16, WS_W1T) + (size_t)l * 10240 * D; bf16* BRT = WSP(bf16, WS_BRT) + (size_t)l * D * YW; bf16* OUTT = WSP(bf16, WS_OUTT) + (size_t)l * D * D;
    constexpr int I_A = 16 * (4608 / 32), I_B = 16 * (1536 / 32), I_G = 16 * (4096 / 32);
    constexpr int I_BA = 8 * 32, I_BB = 16 * 32, I_BC = 8 * 32, I_BD = 8 * 32, I_O = 16 * 32;
    constexpr int NIT = I_A + I_B + I_G + I_BA + I_BB + I_BC + I_BD + I_O;
    for (int it = gw; it < NIT; it += NGW) {
        int r = it;
        if (r < I_A) { tr_job_item(w_in, 6160, 0, D, 4608, W1T, D, 0, 0, r, scr, F.lane); continue; } r -= I_A;
        if (r < I_B) { tr_job_item(w_in, 6160, 4624, D, 1536, W1T, D, 4608, 0, r, scr, F.lane); continue; } r -= I_B;
        if (r < I_G) { tr_job_item(w_gate, 4096, 0, D, 4096, W1T, D, 6144, 0, r, scr, F.lane); continue; } r -= I_G;
        if (r < I_BA) { tr_job_item(F.in[17] + (size_t)l * 512 * D, D, 0, 512, D, BRT, YW, 0, 0, r, scr, F.lane); continue; } r -= I_BA;
        if (r < I_BB) { tr_job_item(F.in[18] + (size_t)l * 1024 * D, D, 0, 1024, D, BRT, YW, 0, 512, r, scr, F.lane); continue; } r -= I_BB;
        if (r < I_BC) { tr_job_item(F.in[19] + (size_t)l * 512 * D, D, 0, 512, D, BRT, YW, 0, 1536, r, scr, F.lane); continue; } r -= I_BC;
        if (r < I_BD) { tr_job_item(F.in[20] + (size_t)l * 512 * D, D, 0, 512, D, BRT, YW, 0, 2048, r, scr, F.lane); continue; } r -= I_BD;
        tr_job_item(F.in[21] + (size_t)l * D * D, D, 0, D, D, OUTT, D, 0, 0, r, scr, F.lane);
    }
    for (int it = gw; it < 4 * 8; it += NGW) { const int g = it >> 3, r = it & 7;
        tr_job_item(F.in[15] + ((size_t)l * 4 + g) * 128 * 128, 128, 0, 128, 128, WSP(bf16, WS_SMALL + SM_POOLT) + ((size_t)l * 4 + g) * 128 * 128, 128, 0, 0, r, scr, F.lane); }
    const int gt = gw * 64 + F.lane, NGT = NGW * 64;
    for (int i = gt; i < 4 * 128 * 128; i += NGT) { const int s = i & 127, t = (i >> 7) & 127; const float v = F.in[13][(size_t)l * 65536 + i];
        WSP(bf16, WS_SMALL + SM_GMW)[(size_t)l * 65536 + i] = f2bf(s <= t ? v : 0.f); }
    for (int i = gt; i < 16 * 1024; i += NGT) { const int k = i >> 4, j = i & 15; WSP(bf16, WS_SMALL + SM_WDT)[(size_t)l * 16384 + j * 1024 + k] = f2bf(w_in[(size_t)k * 6160 + 4608 + j]); }
}
__device__ __forceinline__ void convert_ffn_weights(Frame& F, int gw, int NGW) {
    LAS float* scr = (LAS float*)(F.lds + F.wave * 8448);
    constexpr int I_U = 16 * (2 * DFF / 32), I_D = (DFF / 64) * (D / 32);
    for (int it = gw; it < I_U + I_D; it += NGW) {
        if (it < I_U) tr_up_item(F.in[23], F.in[24], DFF, WSP(bf16, WS_UPT), it, scr, F.lane);
        else tr_job_item(F.in[25], D, 0, DFF, D, WSP(bf16, WS_DNT), DFF, 0, 0, it - I_U, scr, F.lane);
    }
}
__device__ __forceinline__ void convert_moe_weights(Frame& F, int gw, int NGW) {
    LAS float* scr = (LAS float*)(F.lds + F.wave * 16896);
    constexpr int NB_U = 2 * DFE / 32, I_U = (D / 128) * NB_U, NB_D = D / 32, I_D = (DFE / 128) * NB_D;
    for (int it = gw; it < NE * (I_U + I_D); it += NGW) {
        const int e = it / (I_U + I_D), r = it % (I_U + I_D);
        if (r < I_U) { const int kb = r / NB_U, nb = r % NB_U, r0 = 32 * nb, pn = r0 >> 8, sel = (r0 >> 7) & 1, j = r0 & 127;
            const float* src = (sel ? F.in[28] : F.in[27]) + (size_t)e * D * DFE + (size_t)(128 * kb) * DFE + 128 * pn + j;
            tr_item_f8(src, DFE, WSP(unsigned char, WS_MOEUP) + (size_t)e * 2 * DFE * D + (size_t)r0 * D + 128 * kb, D, MOE_UP_WSCALE, scr, F.lane); }
        else { const int q = r - I_U, kb = q / NB_D, nb = q % NB_D;
            const float* src = F.in[29] + (size_t)e * DFE * D + (size_t)(128 * kb) * D + 32 * nb;
            tr_item_f8(src, D, WSP(unsigned char, WS_MOEDN) + (size_t)e * D * DFE + (size_t)(32 * nb) * DFE + 128 * kb, DFE, MOE_DN_WSCALE, scr, F.lane); }
    }
}

__device__ __forceinline__ void rms_row(const float* xrow, const float* g, bf16* orow, int lane, f32x4 (&v)[4]) {
    const f32x4* xr = (const f32x4*)xrow + lane;
    float s = 0.f;
#pragma unroll
    for (int j = 0; j < 4; ++j) { v[j] = xr[64 * j]; s += (v[j].x * v[j].x + v[j].y * v[j].y) + (v[j].z * v[j].z + v[j].w * v[j].w); }
    const float r = 1.0f / sqrtf(wave_sum(s) * (1.f / D) + EPS);
    u32x2* o8 = (u32x2*)orow + lane;
#pragma unroll
    for (int j = 0; j < 4; ++j) { const f32x4 gv = ((const f32x4*)g)[64 * j + lane]; v[j] = v[j] * r * gv; u32x2 w; w.x = cvt_pk_bf16(v[j].x, v[j].y); w.y = cvt_pk_bf16(v[j].z, v[j].w); o8[64 * j] = w; }
}
__device__ __forceinline__ void rms_row_f8(const float* xrow, const float* g, unsigned char* orow, int lane, f32x4 (&v)[4]) {
    const f32x4* xr = (const f32x4*)xrow + lane;
    float s = 0.f;
#pragma unroll
    for (int j = 0; j < 4; ++j) { v[j] = xr[64 * j]; s += (v[j].x * v[j].x + v[j].y * v[j].y) + (v[j].z * v[j].z + v[j].w * v[j].w); }
    const float r = 1.0f / sqrtf(wave_sum(s) * (1.f / D) + EPS);
    unsigned* o4 = (unsigned*)orow + lane;
#pragma unroll
    for (int j = 0; j < 4; ++j) { const f32x4 gv = ((const f32x4*)g)[64 * j + lane]; v[j] = v[j] * r * gv; o4[64 * j] = cvt4_fp8(v[j].x, v[j].y, v[j].z, v[j].w); }
}
__device__ __forceinline__ void rmsnorm_phase(Frame& F, const float* x, const float* g, bf16* out) {
    const int gw = F.bid * NWAVES + F.wave, NGW = F.G * NWAVES;
    for (int m = gw; m < L; m += NGW) { f32x4 v[4]; rms_row(x + (size_t)m * D, g, out + (size_t)m * D, F.lane, v); }
}

__device__ __forceinline__ void route_phase(Frame& F, const float* x, const float* g, unsigned char* out, const float* rw) {
    LAS float* RW = (LAS float*)F.lds;
    LAS int* HC = (LAS int*)(F.lds + 32768);
    for (int i = F.tid; i < 8192; i += NTHR) RW[i] = rw[i];
    if (F.tid < 8) HC[F.tid] = 0;
    __syncthreads();
    unsigned* topk = WSP(unsigned, WS_ROUTE + RT_TOPK);
    for (int rr = 0; rr < 8; ++rr) {
        const int t = F.bid * 64 + F.wave * 8 + rr;
        f32x4 v[4]; rms_row_f8(x + (size_t)t * D, g, out + (size_t)t * D, F.lane, v);
        float lg[8];
#pragma unroll
        for (int e = 0; e < 8; ++e) lg[e] = 0.f;
#pragma unroll
        for (int j = 0; j < 4; ++j)
#pragma unroll
            for (int q = 0; q < 4; ++q) { const int k = 4 * (64 * j + F.lane) + q; const f32x4 w0 = *(const LAS f32x4*)(RW + k * 8), w1 = *(const LAS f32x4*)(RW + k * 8 + 4); const float xv = v[j][q];
                lg[0] += xv * w0.x; lg[1] += xv * w0.y; lg[2] += xv * w0.z; lg[3] += xv * w0.w; lg[4] += xv * w1.x; lg[5] += xv * w1.y; lg[6] += xv * w1.z; lg[7] += xv * w1.w; }
#pragma unroll
        for (int e = 0; e < 8; ++e) lg[e] = wave_sum(lg[e]);
        int i0 = 0; float m0 = lg[0];
#pragma unroll
        for (int e = 1; e < 8; ++e) if (lg[e] > m0) { m0 = lg[e]; i0 = e; }
        int i1 = -1; float m1 = -3.0e38f;
#pragma unroll
        for (int e = 0; e < 8; ++e) if (e != i0 && lg[e] > m1) { m1 = lg[e]; i1 = e; }
        const float e1 = expf(m1 - m0), den = 1.f + e1;
        if (F.lane == 0) { u32x4 o; o.x = (unsigned)i0; o.y = (unsigned)i1; o.z = __float_as_uint(1.f / den); o.w = __float_as_uint(e1 / den); *(u32x4*)(topk + 4 * t) = o;
            atomicAdd((int*)&HC[i0], 1); atomicAdd((int*)&HC[i1], 1); }
    }
    __syncthreads();
    if (F.tid < 8) WSP(int, WS_ROUTE + RT_CNT)[F.bid * 8 + F.tid] = HC[F.tid];
}
__device__ __forceinline__ void assign_phase(Frame& F) {
    LAS int* SB = (LAS int*)F.lds;
    const int* cnt = WSP(int, WS_ROUTE + RT_CNT);
    const unsigned* topk = WSP(unsigned, WS_ROUTE + RT_TOPK);
    int* rowidx = WSP(int, WS_ROUTE + RT_ROWIDX); int* tokslot = WSP(int, WS_ROUTE + RT_TOKSLOT);
    if (F.tid < 8) { int before = 0, tot = 0; for (int b = 0; b < F.G; ++b) { const int c = cnt[b * 8 + F.tid]; tot += c; if (b < F.bid) before += c; } SB[F.tid] = before; SB[16 + F.tid] = tot; }
    __syncthreads();
    if (F.tid == 0) { int off = 0; for (int e = 0; e < 8; ++e) { SB[8 + e] = off; off += (SB[16 + e] + 255) & ~255; } SB[24] = off; }
    __syncthreads();
    if (F.tid < 8) { const int e = F.tid; int run = SB[8 + e] + SB[e];
        for (int i = 0; i < 64; ++i) { const int t = F.bid * 64 + i; const unsigned e0 = topk[4 * t], e1 = topk[4 * t + 1];
            if ((int)e0 == e) { rowidx[run] = t; tokslot[2 * t] = run; ++run; }
            if ((int)e1 == e) { rowidx[run] = t; tokslot[2 * t + 1] = run; ++run; } } }
    if (F.bid < 8) { const int e = F.bid, lo = SB[8 + e] + SB[16 + e], hi = SB[8 + e] + ((SB[16 + e] + 255) & ~255); for (int s = lo + F.tid; s < hi; s += NTHR) rowidx[s] = 0; }
    if (F.bid == 0) { int* tile_e = WSP(int, WS_ROUTE + RT_TILEE); const int nt = SB[24] >> 8;
        for (int i = F.tid; i < nt; i += NTHR) { int e = 0; for (int q = 1; q < 8; ++q) if (i * 256 >= SB[8 + q]) e = q; tile_e[i] = e; }
        if (F.tid == 0) WSP(int, WS_ROUTE + RT_NT)[0] = nt; }
}
struct MoeUpSched {
    pg8::TileOrder o; const char* A; const char* Bt; const int* tile_e; const int* rowidx;
    __device__ __forceinline__ bool next(int i, pg8::Unit& u) const { if (!o.tile(i, u.pm, u.pn)) return false; const int e = __builtin_amdgcn_readfirstlane(tile_e[u.pm]); u.a = A; u.b = Bt + ((size_t)e * 2 * DFE + (size_t)u.pn * 256) * D; return true; }
    __device__ __forceinline__ unsigned arow(const pg8::Unit& u, int r) const { return (unsigned)rowidx[u.pm * 256 + r]; }
};
struct MoeDnSched {
    pg8::TileOrder o; const char* A; const char* Bt; const int* tile_e;
    __device__ __forceinline__ bool next(int i, pg8::Unit& u) const { if (!o.tile(i, u.pm, u.pn)) return false; const int e = __builtin_amdgcn_readfirstlane(tile_e[u.pm]); u.a = A + (size_t)u.pm * 256 * DFE; u.b = Bt + ((size_t)e * D + (size_t)u.pn * 256) * DFE; return true; }
    __device__ __forceinline__ unsigned arow(const pg8::Unit&, int) const { return 0u; }
};
__device__ __forceinline__ void final_phase(Frame& F, const float* x, const bf16* ybuf, const float* g, float* out) {
    const int gw = F.bid * NWAVES + F.wave, NGW = F.G * NWAVES;
    const unsigned* topk = WSP(unsigned, WS_ROUTE + RT_TOPK); const int* tokslot = WSP(int, WS_ROUTE + RT_TOKSLOT);
    for (int t = gw; t < L; t += NGW) {
        const float g0 = __uint_as_float(topk[4 * t + 2]), g1 = __uint_as_float(topk[4 * t + 3]); const int s0 = tokslot[2 * t], s1 = tokslot[2 * t + 1];
        const f32x4* xr = (const f32x4*)(x + (size_t)t * D) + F.lane; const u32x2* y0 = (const u32x2*)(ybuf + (size_t)s0 * D) + F.lane; const u32x2* y1 = (const u32x2*)(ybuf + (size_t)s1 * D) + F.lane;
        f32x4 v[4]; float s = 0.f;
#pragma unroll
        for (int j = 0; j < 4; ++j) { const u32x2 a = y0[64 * j], b = y1[64 * j]; v[j] = xr[64 * j];
            v[j].x += g0 * bflo(a.x) + g1 * bflo(b.x); v[j].y += g0 * bfhi(a.x) + g1 * bfhi(b.x); v[j].z += g0 * bflo(a.y) + g1 * bflo(b.y); v[j].w += g0 * bfhi(a.y) + g1 * bfhi(b.y);
            s += (v[j].x * v[j].x + v[j].y * v[j].y) + (v[j].z * v[j].z + v[j].w * v[j].w); }
        const float r = 1.0f / sqrtf(wave_sum(s) * (1.f / D) + EPS);
        f32x4* o = (f32x4*)(out + (size_t)t * D) + F.lane;
#pragma unroll
        for (int j = 0; j < 4; ++j) o[64 * j] = v[j] * r * ((const f32x4*)g)[64 * j + F.lane];
    }
}
__device__ __forceinline__ u32x4 ld16(const bf16* p) { return *(const u32x4*)p; }
__device__ __forceinline__ u32x2 ld8(const bf16* p) { return *(const u32x2*)p; }

__device__ __forceinline__ void mixer_a(Frame& F, int l, int b) {
    const bf16* P = WSP(bf16, WS_PROJ); bf16* Y = WSP(bf16, WS_YCAT); const float* cw = F.in[4] + (size_t)l * 3 * 512;
    const int c0 = 8 * F.lane, tb = 64 * b + 8 * F.wave;
    float w0[8], w1[8], w2[8];
#pragma unroll
    for (int j = 0; j < 8; ++j) { w0[j] = cw[c0 + j]; w1[j] = cw[512 + c0 + j]; w2[j] = cw[1024 + c0 + j]; }
    float pm2[8], pm1[8];
#pragma unroll
    for (int r = -2; r < 8; ++r) {
        const int t = tb + r; float pr[8];
        if (t >= 0) { float ah[8], ac[8]; unpack8(ld16(P + (size_t)t * PW + c0), ah); unpack8(ld16(P + (size_t)t * PW + 1024 + c0), ac);
#pragma unroll
            for (int j = 0; j < 8; ++j) pr[j] = ah[j] * ac[j]; }
        else {
#pragma unroll
            for (int j = 0; j < 8; ++j) pr[j] = 0.f; }
        if (r >= 0) { float ab[8], o[8]; unpack8(ld16(P + (size_t)t * PW + 512 + c0), ab);
#pragma unroll
            for (int j = 0; j < 8; ++j) o[j] = ab[j] * (w0[j] * pm2[j] + w1[j] * pm1[j] + w2[j] * pr[j]);
            *(u32x4*)(Y + (size_t)t * YW + c0) = pack8(o); }
#pragma unroll
        for (int j = 0; j < 8; ++j) { pm2[j] = pm1[j]; pm1[j] = pr[j]; }
    }
}

__device__ __forceinline__ void mixer_d(Frame& F, int l, int b) {
    const bf16* P = WSP(bf16, WS_PROJ); bf16* Y = WSP(bf16, WS_YCAT);
    LAS unsigned char* RAW = F.lds;
    LAS unsigned char* PL = F.lds + 20480;
    const int t0 = 64 * b, fr = F.lane & 15, fq = F.lane >> 4;
    for (int g = 0; g < 4; ++g) {
        const int win = 2 << g;
        for (int i = F.tid; i < 79 * 16; i += NTHR) { const int r = i >> 4, c8 = i & 15, t = t0 - 15 + r;
            u32x4 v = (u32x4){0u, 0u, 0u, 0u}; if (t >= 0) v = ld16(P + (size_t)t * PW + 5632 + g * 128 + 8 * c8);
            *(LAS u32x4*)(RAW + r * 256 + c8 * 16) = v; }
        __syncthreads();
        for (int i = F.tid; i < 64 * 16; i += NTHR) { const int r = i >> 4, c8 = i & 15, t = t0 + r;
            float s[8], x0[8];
#pragma unroll
            for (int j = 0; j < 8; ++j) s[j] = 0.f;
            for (int k = 0; k < win; ++k) { float x[8]; unpack8(*(const LAS u32x4*)(RAW + (r + 15 - k) * 256 + c8 * 16), x);
#pragma unroll
                for (int j = 0; j < 8; ++j) s[j] += x[j];
                if (k == 0) {
#pragma unroll
                    for (int j = 0; j < 8; ++j) x0[j] = x[j]; } }
            const float inv = 1.0f / (float)((t + 1 < win) ? t + 1 : win);
#pragma unroll
            for (int j = 0; j < 8; ++j) s[j] = s[j] * inv - x0[j];
            *(LAS u32x4*)(PL + r * 272 + c8 * 16) = pack8(s); }
        __syncthreads();
        const bf16* Q = WSP(bf16, WS_SMALL + SM_POOLT) + ((size_t)l * 4 + g) * 128 * 128 + (size_t)(16 * F.wave + fr) * 128 + 8 * fq;
        f32x4 acc[4];
#pragma unroll
        for (int m = 0; m < 4; ++m) acc[m] = (f32x4){0.f, 0.f, 0.f, 0.f};
#pragma unroll
        for (int kk = 0; kk < 4; ++kk) { const bf16x8 q = gfrag(Q + 32 * kk);
#pragma unroll
            for (int m = 0; m < 4; ++m) { const bf16x8 p = ldsfrag(PL, (16 * m + fr) * 272 + (32 * kk + 8 * fq) * 2); MMA16(acc[m], q, p); } }
        const int d0 = 16 * F.wave + 4 * fq; const f32x4 sc = *(const f32x4*)(F.in[16] + (size_t)l * 512 + g * 128 + d0);
#pragma unroll
        for (int m = 0; m < 4; ++m) { const f32x4 v = acc[m] * sc; u32x2 w; w.x = cvt_pk_bf16(v[0], v[1]); w.y = cvt_pk_bf16(v[2], v[3]);
            *(u32x2*)(Y + (size_t)(t0 + 16 * m + fr) * YW + 2048 + g * 128 + d0) = w; }
        __syncthreads();
    }
}

__device__ __forceinline__ void mixer_c(Frame& F, int l, int blk, int gp) {
    const bf16* P = WSP(bf16, WS_PROJ); bf16* Y = WSP(bf16, WS_YCAT);
    LAS float* MU = (LAS float*)F.lds; LAS float* RS = (LAS float*)(F.lds + 512); LAS unsigned char* VT = F.lds + 1024;
    const int t0 = 128 * blk, fr = F.lane & 15, fq = F.lane >> 4;
    for (int i = 0; i < 16; ++i) { const int row = 16 * F.wave + i; float x[8]; unpack8(ld16(P + (size_t)(t0 + row) * PW + 5120 + 8 * F.lane), x);
        float s = 0.f, q = 0.f;
#pragma unroll
        for (int j = 0; j < 8; ++j) { s += x[j]; q += x[j] * x[j]; }
        s = wave_sum(s); q = wave_sum(q);
        if (F.lane == 0) { const float mu = s * (1.f / 512.f); const float var = fmaxf(q * (1.f / 512.f) - mu * mu, 0.f); MU[row] = mu; RS[row] = 1.0f / sqrtf(var + EPS); } }
    __syncthreads();
    { const int ch8 = F.lane & 31, par = F.lane >> 5, cv = gp * 256 + 8 * ch8;
      float lg[8], lb[8];
#pragma unroll
      for (int j = 0; j < 8; ++j) { lg[j] = F.in[11][(size_t)l * 512 + cv + j]; lb[j] = F.in[12][(size_t)l * 512 + cv + j]; }
      for (int i = 0; i < 8; ++i) { const int row = 16 * F.wave + 2 * i + par; float x[8]; unpack8(ld16(P + (size_t)(t0 + row) * PW + 5120 + cv), x);
          const float mu = MU[row], rs = RS[row];
#pragma unroll
          for (int j = 0; j < 8; ++j) *(LAS bf16*)(VT + (8 * ch8 + j) * 272 + row * 2) = f2bf((x[j] - mu) * rs * lg[j] + lb[j]); } }
    __syncthreads();
    const int g = 2 * gp + (F.wave >> 2);
    const bf16* Wm = WSP(bf16, WS_SMALL + SM_GMW) + ((size_t)l * 4 + g) * 128 * 128;
    f32x4 acc[8][2];
#pragma unroll
    for (int m = 0; m < 8; ++m) { acc[m][0] = (f32x4){0.f, 0.f, 0.f, 0.f}; acc[m][1] = (f32x4){0.f, 0.f, 0.f, 0.f}; }
#pragma unroll
    for (int m = 0; m < 8; ++m) {
#pragma unroll
        for (int kk = 0; kk < 4; ++kk) if (kk <= (m >> 1)) { const bf16x8 p = gfrag(Wm + (size_t)(16 * m + fr) * 128 + 32 * kk + 8 * fq);
#pragma unroll
            for (int x = 0; x < 2; ++x) { const bf16x8 q = ldsfrag(VT, (16 * (2 * F.wave + x) + fr) * 272 + (32 * kk + 8 * fq) * 2); MMA16(acc[m][x], q, p); } } }
#pragma unroll
    for (int m = 0; m < 8; ++m) { const int tl = 16 * m + fr; const float bias = F.in[14][((size_t)l * 4 + g) * 128 + tl];
#pragma unroll
        for (int x = 0; x < 2; ++x) { const int cl = 16 * ((2 * F.wave + x) & 7) + 4 * fq; const u32x2 u = ld8(P + (size_t)(t0 + tl) * PW + 4608 + g * 128 + cl);
            const f32x4 a = acc[m][x]; u32x2 w; w.x = cvt_pk_bf16(bflo(u.x) * (a[0] + bias), bfhi(u.x) * (a[1] + bias)); w.y = cvt_pk_bf16(bflo(u.y) * (a[2] + bias), bfhi(u.y) * (a[3] + bias));
            *(u32x2*)(Y + (size_t)(t0 + tl) * YW + 1536 + g * 128 + cl) = w; } }
    __syncthreads();
}

constexpr int S1_DTV = 0, S1_DAC = 4096, S1_WV = 8192, S1_RED = 12288, S1_CL = 12288, S1_BL = 29696, S1_BT = 47104, S1_XT = 65536, S1_SH = 102400;
__device__ __forceinline__ void ssd1_chunk(Frame& F, int l, int c) {
    const bf16* P = WSP(bf16, WS_PROJ); bf16* Y = WSP(bf16, WS_YCAT); const bf16* H = WSP(bf16, WS_H);
    LAS unsigned char* lds = F.lds; LAS float* DTV = (LAS float*)(lds + S1_DTV); LAS float* DAC = (LAS float*)(lds + S1_DAC); LAS float* WV = (LAS float*)(lds + S1_WV); LAS float* RED = (LAS float*)(lds + S1_RED);
    const int t0 = 64 * c, fr = F.lane & 15, fq = F.lane >> 4, wave = F.wave, lane = F.lane;
    { f32x4 acc[4];
#pragma unroll
      for (int m = 0; m < 4; ++m) acc[m] = (f32x4){0.f, 0.f, 0.f, 0.f};
      const bf16* Hp = H + (size_t)(t0 + fr) * D + wave * 128 + 8 * fq; const bf16* Wd = WSP(bf16, WS_SMALL + SM_WDT) + (size_t)l * 16384 + fr * 1024 + wave * 128 + 8 * fq;
#pragma unroll
      for (int kk = 0; kk < 4; ++kk) { const bf16x8 q = gfrag(Wd + 32 * kk);
#pragma unroll
          for (int m = 0; m < 4; ++m) { const bf16x8 p = gfrag(Hp + (size_t)(16 * m) * D + 32 * kk); MMA16(acc[m], q, p); } }
#pragma unroll
      for (int m = 0; m < 4; ++m) *(LAS f32x4*)(RED + (wave * 64 + 16 * m + fr) * 16 + 4 * fq) = acc[m]; }
    __syncthreads();
    for (int o = F.tid; o < 1024; o += NTHR) { float s = 0.f;
#pragma unroll
        for (int w = 0; w < 8; ++w) s += RED[w * 1024 + o];
        const int j = o & 15; const float dt = softplus_f(s + F.in[7][l * 16 + j]); DTV[o] = dt; DAC[o] = -expf(F.in[8][l * 16 + j]) * dt; }
    __syncthreads();
    if (F.tid < 16) { float run = 0.f; for (int t = 0; t < 64; ++t) { run += DAC[t * 16 + F.tid]; DAC[t * 16 + F.tid] = run; } }
    __syncthreads();
    for (int o = F.tid; o < 1024; o += NTHR) { const int j = o & 15; WV[o] = DTV[o] * expf(DAC[63 * 16 + j] - DAC[o]); WSP(float, WS_DACS)[(size_t)t0 * 16 + o] = DAC[o]; }
    __syncthreads();
    for (int g = 0; g < 4; ++g) {
        { const int chx = lane < 32 ? g * 256 + 8 * lane : (lane < 48 ? 1024 + g * 128 + 8 * (lane - 32) : 1536 + g * 128 + 8 * (lane - 48));
          const float* cw = F.in[5] + (size_t)l * 4 * 2048 + chx; const float* cb = F.in[6] + (size_t)l * 2048 + chx;
          float w0[8], w1[8], w2[8], w3[8], bi[8];
#pragma unroll
          for (int j = 0; j < 8; ++j) { w0[j] = cw[j]; w1[j] = cw[2048 + j]; w2[j] = cw[4096 + j]; w3[j] = cw[6144 + j]; bi[j] = cb[j]; }
          u32x4 raw[11];
#pragma unroll
          for (int r = 0; r < 11; ++r) { const int t = t0 + 8 * wave + r - 3; raw[r] = (u32x4){0u, 0u, 0u, 0u}; if (t >= 0) raw[r] = ld16(P + (size_t)t * PW + 2560 + chx); }
          float x3[8], x2[8], x1[8]; unpack8(raw[0], x3); unpack8(raw[1], x2); unpack8(raw[2], x1);
          float prev[8];
#pragma unroll
          for (int r = 0; r < 8; ++r) { float x0[8], o[8]; unpack8(raw[3 + r], x0); const int row = 8 * wave + r;
#pragma unroll
              for (int j = 0; j < 8; ++j) { o[j] = silu_f(bi[j] + w0[j] * x3[j] + w1[j] * x2[j] + w2[j] * x1[j] + w3[j] * x0[j]); x3[j] = x2[j]; x2[j] = x1[j]; x1[j] = x0[j]; }
              if (lane >= 48) { const u32x4 pk = pack8(o); const int n0 = 8 * (lane - 48); *(LAS u32x4*)(lds + S1_CL + row * 272 + n0 * 2) = pk; *(u32x4*)(WSP(bf16, WS_CC) + (size_t)(t0 + row) * 512 + g * 128 + n0) = pk; }
              else if (lane >= 32) { const int n0 = 8 * (lane - 32); *(LAS u32x4*)(lds + S1_BL + row * 272 + n0 * 2) = pack8(o);
                  if (r & 1) {
#pragma unroll
                      for (int j = 0; j < 8; ++j) *(LAS unsigned*)(lds + S1_BT + (n0 + j) * 144 + (row - 1) * 2) = cvt_pk_bf16(prev[j], o[j]); } }
              else { const int hl = lane >> 3, p0 = 8 * (lane & 7);
                  if (r & 1) {
#pragma unroll
                      for (int j = 0; j < 8; ++j) *(LAS unsigned*)(lds + S1_XT + ((hl * 64 + p0 + j) * 72 + (row - 1)) * 2) = cvt_pk_bf16(prev[j], o[j]); } }
#pragma unroll
              for (int j = 0; j < 8; ++j) prev[j] = o[j]; } }
        __syncthreads();
        { const int mi = wave >> 1, nb = (wave & 1) * 2;
          f32x4 cbv[2] = {(f32x4){0.f, 0.f, 0.f, 0.f}, (f32x4){0.f, 0.f, 0.f, 0.f}};
#pragma unroll
          for (int kk = 0; kk < 4; ++kk) { const bf16x8 p = ldsfrag(lds, S1_CL + (16 * mi + fr) * 272 + (32 * kk + 8 * fq) * 2);
#pragma unroll
              for (int x = 0; x < 2; ++x) if (nb + x <= mi) { const bf16x8 q = ldsfrag(lds, S1_BL + (16 * (nb + x) + fr) * 272 + (32 * kk + 8 * fq) * 2); MMA16(cbv[x], q, p); } }
          const int lrow = 16 * mi + fr;
#pragma unroll
          for (int hl = 0; hl < 4; ++hl) { const int hh = 4 * g + hl; const float dl = DAC[lrow * 16 + hh];
#pragma unroll
              for (int x = 0; x < 2; ++x) { const int s0 = 16 * (nb + x) + 4 * fq; float v[4];
#pragma unroll
                  for (int r = 0; r < 4; ++r) { const int s = s0 + r; const bool ok = (nb + x <= mi) && (s <= lrow); const float e = ok ? fast_exp(fminf(dl - DAC[s * 16 + hh], 0.f)) * DTV[s * 16 + hh] : 0.f; v[r] = ok ? cbv[x][r] * e : 0.f; }
                  u32x2 w; w.x = cvt_pk_bf16(v[0], v[1]); w.y = cvt_pk_bf16(v[2], v[3]);
                  *(LAS u32x2*)(lds + S1_SH + ((hl * 64 + lrow) * 72 + s0) * 2) = w; } } }
        __syncthreads();
        { const int hl = wave >> 1, hh = 4 * g + hl;
          const float dsk = F.in[9][l * 16 + hh];
#pragma unroll
          for (int m2 = 0; m2 < 2; ++m2) { const int mi = 2 * (wave & 1) + m2, nk = (mi >> 1) + 1;
              f32x4 y[4];
#pragma unroll
              for (int pi = 0; pi < 4; ++pi) y[pi] = (f32x4){0.f, 0.f, 0.f, 0.f};
#pragma unroll
              for (int kk = 0; kk < 2; ++kk) if (kk < nk) { const bf16x8 p = ldsfrag(lds, S1_SH + ((hl * 64 + 16 * mi + fr) * 72 + 32 * kk + 8 * fq) * 2);
#pragma unroll
                  for (int pi = 0; pi < 4; ++pi) { const bf16x8 q = ldsfrag(lds, S1_XT + ((hl * 64 + 16 * pi + fr) * 72 + 32 * kk + 8 * fq) * 2); MMA16(y[pi], q, p); } }
              const int lrow = 16 * mi + fr;
#pragma unroll
              for (int pi = 0; pi < 4; ++pi) { const int p0 = 16 * pi + 4 * fq; float xs[4];
#pragma unroll
                  for (int r = 0; r < 4; ++r) xs[r] = bf1(*(const LAS bf16*)(lds + S1_XT + ((hl * 64 + p0 + r) * 72 + lrow) * 2));
                  u32x2 w; w.x = cvt_pk_bf16(y[pi][0] + dsk * xs[0], y[pi][1] + dsk * xs[1]); w.y = cvt_pk_bf16(y[pi][2] + dsk * xs[2], y[pi][3] + dsk * xs[3]);
                  *(u32x2*)(Y + (size_t)(t0 + lrow) * YW + 512 + hh * 64 + p0) = w; } }
          f32x4 st[4][4];
#pragma unroll
          for (int pi = 0; pi < 4; ++pi)
#pragma unroll
              for (int nx = 0; nx < 4; ++nx) st[pi][nx] = (f32x4){0.f, 0.f, 0.f, 0.f};
#pragma unroll
          for (int kk = 0; kk < 2; ++kk) { float wv[8];
#pragma unroll
              for (int j = 0; j < 8; ++j) wv[j] = WV[(32 * kk + 8 * fq + j) * 16 + hh];
              bf16x8 pa[4];
#pragma unroll
              for (int pi = 0; pi < 4; ++pi) { float xv[8]; unpack8(*(const LAS u32x4*)(lds + S1_XT + ((hl * 64 + 16 * pi + fr) * 72 + 32 * kk + 8 * fq) * 2), xv);
#pragma unroll
                  for (int j = 0; j < 8; ++j) xv[j] *= wv[j];
                  const u32x4 pk = pack8(xv); pa[pi] = __builtin_bit_cast(bf16x8, pk); }
#pragma unroll
              for (int nx = 0; nx < 4; ++nx) { const bf16x8 q = ldsfrag(lds, S1_BT + (16 * (4 * (wave & 1) + nx) + fr) * 144 + (32 * kk + 8 * fq) * 2);
#pragma unroll
                  for (int pi = 0; pi < 4; ++pi) MMA16(st[pi][nx], q, pa[pi]); } }
          bf16* ST = WSP(bf16, WS_STATES) + ((size_t)c * 16 + hh) * 8192;
#pragma unroll
          for (int pi = 0; pi < 4; ++pi)
#pragma unroll
              for (int nx = 0; nx < 4; ++nx) { const f32x4 v = st[pi][nx]; u32x2 w; w.x = cvt_pk_bf16(v[0], v[1]); w.y = cvt_pk_bf16(v[2], v[3]);
                  *(u32x2*)(ST + (size_t)(16 * pi + fr) * 128 + 16 * (4 * (wave & 1) + nx) + 4 * fq) = w; } }
        __syncthreads();
    }
}

template <bool DUMMY = false> __device__ __forceinline__ void scan_phase(Frame& F) {
    const int e = F.bid * NTHR + F.tid, hh = e >> 13;
    bf16* ST = WSP(bf16, WS_STATES) + e; const float* DA = WSP(float, WS_DACS) + 63 * 16 + hh;
    float run = 0.f;
    for (int cb = 0; cb < 256; cb += 16) { bf16 s[16]; float d[16];
#pragma unroll
        for (int i = 0; i < 16; ++i) { s[i] = ST[(size_t)(cb + i) * 131072]; d[i] = DA[(size_t)(cb + i) * 64 * 16]; }
#pragma unroll
        for (int i = 0; i < 16; ++i) { if (!DUMMY) ST[(size_t)(cb + i) * 131072] = f2bf(run); run = run * expf(d[i]) + bf1(s[i]); } }
    if (DUMMY) WSP(float, WS_R + 386 * MiB)[e] = run;
}

template <bool DUMMY = false> __device__ __forceinline__ void ssd3_chunk(Frame& F, int l, int c) {
    const bf16* P = WSP(bf16, WS_PROJ); bf16* Y = WSP(bf16, WS_YCAT); bf16* YO = DUMMY ? WSP(bf16, WS_PROJ) : Y; const int yo_pitch = DUMMY ? PW : YW, yo_col = DUMMY ? 0 : 512; const bf16* CCp = WSP(bf16, WS_CC); const float* DACS = WSP(float, WS_DACS);
    LAS float* SQ = (LAS float*)F.lds;
    const int t0 = 64 * c, fr = F.lane & 15, fq = F.lane >> 4, wave = F.wave;
    for (int g = 0; g < 4; ++g) {
        const int hl = wave >> 1, hh = 4 * g + hl, pb = 2 * (wave & 1);
        const bf16* HI = WSP(bf16, WS_STATES) + ((size_t)c * 16 + hh) * 8192;
        bf16x8 hq[2][4];
#pragma unroll
        for (int px = 0; px < 2; ++px)
#pragma unroll
            for (int kk = 0; kk < 4; ++kk) hq[px][kk] = gfrag(HI + (size_t)(16 * (pb + px) + fr) * 128 + 32 * kk + 8 * fq);
        f32x4 y[4][2];
#pragma unroll
        for (int mi = 0; mi < 4; ++mi) { y[mi][0] = (f32x4){0.f, 0.f, 0.f, 0.f}; y[mi][1] = (f32x4){0.f, 0.f, 0.f, 0.f};
#pragma unroll
            for (int kk = 0; kk < 4; ++kk) { const bf16x8 p = gfrag(CCp + (size_t)(t0 + 16 * mi + fr) * 512 + g * 128 + 32 * kk + 8 * fq);
#pragma unroll
                for (int px = 0; px < 2; ++px) MMA16(y[mi][px], hq[px][kk], p); } }
#pragma unroll
        for (int mi = 0; mi < 4; ++mi) { const int t = t0 + 16 * mi + fr; const float e = expf(DACS[(size_t)t * 16 + hh]); float sq = 0.f;
#pragma unroll
            for (int px = 0; px < 2; ++px) { const int ch = hh * 64 + 16 * (pb + px) + 4 * fq; const u32x2 yd = ld8(Y + (size_t)t * YW + 512 + ch), z = ld8(P + (size_t)t * PW + 1536 + ch);
                f32x4 v; v[0] = (bflo(yd.x) + e * y[mi][px][0]) * silu_f(bflo(z.x)); v[1] = (bfhi(yd.x) + e * y[mi][px][1]) * silu_f(bfhi(z.x));
                v[2] = (bflo(yd.y) + e * y[mi][px][2]) * silu_f(bflo(z.y)); v[3] = (bfhi(yd.y) + e * y[mi][px][3]) * silu_f(bfhi(z.y));
                y[mi][px] = v; sq += (v[0] * v[0] + v[1] * v[1]) + (v[2] * v[2] + v[3] * v[3]); }
            sq += __shfl_xor(sq, 16); sq += __shfl_xor(sq, 32);
            if (fq == 0) SQ[wave * 64 + 16 * mi + fr] = sq; }
        __syncthreads();
#pragma unroll
        for (int mi = 0; mi < 4; ++mi) { const int lr = 16 * mi + fr, t = t0 + lr; float tot = 0.f;
#pragma unroll
            for (int w = 0; w < 8; ++w) tot += SQ[w * 64 + lr];
            const float rstd = 1.0f / sqrtf(tot * (1.f / 256.f) + EPS);
#pragma unroll
            for (int px = 0; px < 2; ++px) { const int ch = hh * 64 + 16 * (pb + px) + 4 * fq; const f32x4 ng = *(const f32x4*)(F.in[10] + (size_t)l * 1024 + ch); const f32x4 v = y[mi][px] * rstd * ng;
                u32x2 w; w.x = cvt_pk_bf16(v[0], v[1]); w.y = cvt_pk_bf16(v[2], v[3]); *(u32x2*)(YO + (size_t)t * yo_pitch + yo_col + ch) = w; } }
        __syncthreads();
    }
}
struct Args { const float* in[31]; float* out; unsigned char* ws; int ph_lo, ph_hi; };
constexpr int PH_PER_LAYER = 12, N_PHASES = 2 + 2 * PH_PER_LAYER;

#ifndef PMASK
#define PMASK 0x3fff
#endif
#define IN(k) (lo <= (k) && (k) < hi)
#define EN(b) ((PMASK >> (b)) & 1)
#ifndef REPMASK
#define REPMASK 0
#endif
#define NREP(b) (((REPMASK >> (b)) & 1) ? 2 : 1)
#define PHASE_BEGIN() do { int _t = threadIdx.x; asm volatile("" : "+v"(_t)); F.tid = _t; F.lane = _t & 63; } while (0)
#define REPEAT(b, ...) do { _Pragma("unroll") for (int _r = 0; _r < NREP(b); ++_r) { __VA_ARGS__; } } while (0)
#define REPEAT1(b, ...) do { _Pragma("unroll") for (int _r = 0; _r < NREP(b); ++_r) { PHASE_BEGIN(); __VA_ARGS__; } } while (0)
#define SEAM(k) do { if (IN((k) + 1) && MK_N_LAUNCHES == 1) xcd_barrier(bar); } while (0)
template <int l> __device__ __forceinline__ void layer_phases(Frame& F, const XcdBarrier& bar, const int lo, const int hi) {
    const int gw = F.bid * NWAVES + F.wave, NGW = F.G * NWAVES;
    LAS unsigned char* ring = F.lds;
        const int pb = 1 + PH_PER_LAYER * l;
        const float* xin = (l == 0) ? F.in[0] : WSP(float, WS_XC);
        const bf16* W1T = WSP(bf16, WS_W1T) + (size_t)l * 10240 * D;
        if (EN(1) && IN(pb + 0) && l == 1) { PHASE_BEGIN(); rmsnorm_phase(F, xin, F.in[1] + D, WSP(bf16, WS_H)); SEAM(pb + 0); }
        if (EN(2) && IN(pb + 1)) { PHASE_BEGIN();
            pg8::DenseSched S; S.init(WSP(bf16, WS_H), W1T, L, PW, D, F.G, F.bid);
            pg8::EpiBf16Act E{WSP(bf16, WS_PROJ), PW, 18, 22, 0};
            REPEAT(2, pg8::gemm_phase<pg8::EpiBf16Act, pg8::DenseSched, true, false>(ring, D, S, E));
            SEAM(pb + 1);
        }
        if (EN(3) && IN(pb + 2)) { PHASE_BEGIN();
#ifndef MIXMASK
#define MIXMASK 15
#endif
            #ifndef MIXREP
#define MIXREP 15
#endif
            REPEAT1(3, const int mm = (_r == 0) ? 15 : MIXREP; if (mm & 1) ssd1_chunk(F, l, F.bid); if (mm & 2) mixer_c(F, l, F.bid >> 1, F.bid & 1); if (mm & 4) mixer_d(F, l, F.bid); if (mm & 8) mixer_a(F, l, F.bid); __syncthreads());
            SEAM(pb + 2);
        }
        if (EN(4) && IN(pb + 3)) { PHASE_BEGIN(); if (NREP(4) == 2) { scan_phase<true>(F); PHASE_BEGIN(); } scan_phase<false>(F); SEAM(pb + 3); }
        if (EN(5) && IN(pb + 4)) { PHASE_BEGIN(); if (NREP(5) == 2) { ssd3_chunk<true>(F, l, F.bid); PHASE_BEGIN(); } ssd3_chunk<false>(F, l, F.bid); SEAM(pb + 4); }
        if (EN(6) && IN(pb + 5)) { PHASE_BEGIN();
            pg8::DenseSched S; S.init(WSP(bf16, WS_H), W1T + (size_t)PW * D, L, GW, D, F.G, F.bid);
            pg8::EpiBf16Act E{WSP(bf16, WS_GATES), GW, 0, 0, 1};
            REPEAT(6, pg8::gemm_phase<pg8::EpiBf16Act, pg8::DenseSched, true, false>(ring, D, S, E));
            SEAM(pb + 5);
        }
        if (EN(7) && IN(pb + 6)) { PHASE_BEGIN();
            pg8::DenseSched S; S.init(WSP(bf16, WS_YCAT), WSP(bf16, WS_BRT) + (size_t)l * D * YW, L, D, YW, F.G, F.bid);
            pg8::EpiMerge E{WSP(bf16, WS_GATES), WSP(bf16, WS_MERGED)};
            REPEAT(7, pg8::gemm_phase<pg8::EpiMerge, pg8::DenseSched, false, false>(ring, YW, S, E));
            SEAM(pb + 6);
        }
        if (EN(8) && IN(pb + 7)) { PHASE_BEGIN();
            pg8::DenseSched S; S.init(WSP(bf16, WS_MERGED), WSP(bf16, WS_OUTT) + (size_t)l * D * D, L, D, D, F.G, F.bid);
            pg8::EpiResid E{xin, WSP(float, WS_XC), D};
            pg8::gemm_phase<pg8::EpiResid, pg8::DenseSched, false, false>(ring, D, S, E);
            SEAM(pb + 7);
        }
        if (EN(9) && IN(pb + 8)) { PHASE_BEGIN();
            REPEAT(9, if (l == 0) rmsnorm_phase(F, WSP(float, WS_XC), F.in[22], WSP(bf16, WS_H2)); else { route_phase(F, WSP(float, WS_XC), F.in[22] + D, WSP(unsigned char, WS_H2), F.in[26]); __syncthreads(); convert_moe_weights(F, gw, NGW); __syncthreads(); });
            SEAM(pb + 8);
        }
        if (EN(10) && IN(pb + 9) && l == 1) { PHASE_BEGIN(); assign_phase(F); SEAM(pb + 9); }
        if (EN(11) && IN(pb + 10)) { PHASE_BEGIN();
            if (l == 0) {
                pg8::DenseSched S; S.init(WSP(bf16, WS_H2), WSP(bf16, WS_UPT), L, 2 * DFF, D, F.G, F.bid);
                pg8::EpiSwiglu E{WSP(bf16, WS_ACT), DFF};
                REPEAT(11, pg8::gemm_phase<pg8::EpiSwiglu, pg8::DenseSched, true, false>(ring, D, S, E));
            } else {
                MoeUpSched S; S.o.init(__builtin_amdgcn_readfirstlane(WSP(int, WS_ROUTE + RT_NT)[0]), 2 * DFE / 256, F.G, F.bid); S.A = (const char*)WSP(bf16, WS_H2); S.Bt = (const char*)WSP(bf16, WS_MOEUP);
                S.tile_e = WSP(int, WS_ROUTE + RT_TILEE); S.rowidx = WSP(int, WS_ROUTE + RT_ROWIDX);
                pg8::EpiSwigluF8 E{WSP(unsigned char, WS_ACTM), DFE, 1.f / MOE_UP_WSCALE};
                REPEAT(11, pg8::gemm_phase<pg8::EpiSwigluF8, MoeUpSched, true, true, 1>(ring, D, S, E));
            }
            SEAM(pb + 10);
        }
        if (EN(12) && IN(pb + 11)) { PHASE_BEGIN();
            if (l == 0) {
                pg8::DenseSched S; S.init(WSP(bf16, WS_ACT), WSP(bf16, WS_DNT), L, D, DFF, F.G, F.bid);
                pg8::EpiResid E{WSP(float, WS_XC), WSP(float, WS_XC), D};
                pg8::gemm_phase<pg8::EpiResid, pg8::DenseSched, false, false>(ring, DFF, S, E);
            } else {
                MoeDnSched S; S.o.init(__builtin_amdgcn_readfirstlane(WSP(int, WS_ROUTE + RT_NT)[0]), D / 256, F.G, F.bid); S.A = (const char*)WSP(bf16, WS_ACTM); S.Bt = (const char*)WSP(bf16, WS_MOEDN); S.tile_e = WSP(int, WS_ROUTE + RT_TILEE);
                pg8::EpiBf16Scale E{WSP(bf16, WS_YBUF), D, 1.f / MOE_DN_WSCALE};
                REPEAT(12, pg8::gemm_phase<pg8::EpiBf16Scale, MoeDnSched, true, false, 1>(ring, DFE, S, E));
            }
            SEAM(pb + 11);
        }

}
__global__ void __launch_bounds__(NTHR, 2) fwd_kernel(Args args) {
    extern __shared__ __attribute__((aligned(16))) unsigned char lds_raw[];
    Frame F;
    F.lds = (LAS unsigned char*)lds_raw;
    F.MISC = (volatile LAS unsigned*)(F.lds + MISC_OFF);
    F.tid = threadIdx.x; F.lane = F.tid & 63; F.wave = __builtin_amdgcn_readfirstlane(F.tid >> 6);
    F.G = gridDim.x; F.bid = blockIdx.x;
    F.ws = args.ws; F.ctl = (unsigned*)(args.ws + WS_CTL); F.in = args.in; F.out = args.out;
    for (int u = F.tid; u < (LDS_BYTES - MISC_OFF) / 4; u += NTHR) ((LAS unsigned*)(F.lds + MISC_OFF))[u] = 0u;
    __syncthreads();
    XcdBarrier bar; bar.bar = F.ctl + CW_BAR; bar.x = 0; bar.st = nullptr;
    if (MK_N_LAUNCHES == 1) bar = xcd_barrier_post(F.ctl + CW_BAR, F.MISC + 8);
    const int lo = args.ph_lo, hi = args.ph_hi;
    const int gw = F.bid * NWAVES + F.wave, NGW = F.G * NWAVES;
    LAS unsigned char* ring = F.lds;

    if (EN(0) && IN(0)) { PHASE_BEGIN();
        REPEAT(0, convert_layer_weights(F, 0, gw, NGW); convert_layer_weights(F, 1, gw, NGW); convert_ffn_weights(F, gw, NGW); rmsnorm_phase(F, F.in[0], F.in[1], WSP(bf16, WS_H)); __syncthreads());
        SEAM(0);
#ifdef EXTRA_BARS
        for (int i = 0; i < EXTRA_BARS; ++i) xcd_barrier(bar);
#endif
    }
#ifndef LMASK
#define LMASK 3
#endif
    if (LMASK & 1) layer_phases<0>(F, bar, lo, hi);
    if (LMASK & 2) layer_phases<1>(F, bar, lo, hi);
    if (EN(13) && IN(N_PHASES - 1)) final_phase(F, WSP(float, WS_XC), WSP(bf16, WS_YBUF), F.in[30], F.out);
#undef IN
#undef SEAM
}

extern "C" void kernel_launch(void* const* d_in, const int* in_sizes, int n_in, void* d_out, int out_size, void* d_ws, size_t ws_size, hipStream_t stream) {
    static int grid = 0;
    if (grid == 0) {
        if (n_in != 31 || in_sizes[0] != L * D || out_size != L * D || ws_size < WS_END) { fprintf(stderr, "kernel_launch: unexpected problem (n_in %d, out %d, ws %zu); nothing launched\n", n_in, out_size, ws_size); grid = -1; return; }
        int dev = 0, cus = 0, per_cu = 0;
        if (hipGetDevice(&dev) != hipSuccess || hipDeviceGetAttribute(&cus, hipDeviceAttributeMultiprocessorCount, dev) != hipSuccess) { grid = -1; return; }
        if (hipFuncSetAttribute((const void*)fwd_kernel, hipFuncAttributeMaxDynamicSharedMemorySize, LDS_BYTES) != hipSuccess) { fprintf(stderr, "kernel_launch: hipFuncSetAttribute failed\n"); grid = -1; return; }
        if (hipOccupancyMaxActiveBlocksPerMultiprocessor(&per_cu, (const void*)fwd_kernel, NTHR, LDS_BYTES) != hipSuccess || per_cu < 1) { fprintf(stderr, "kernel_launch: occupancy query reports %d workgroups per CU\n", per_cu); (void)hipGetLastError(); grid = -1; return; }
        if (cus != 256) { fprintf(stderr, "kernel_launch: built for 256 CUs, found %d\n", cus); grid = -1; return; }
        grid = 256;
    }
    if (grid < 0) return;
    if (hipMemsetAsync((char*)d_ws + WS_CTL, 0, CTL_ZERO_BYTES, stream) != hipSuccess) return;
    Args a{};
    for (int i = 0; i < 31; ++i) a.in[i] = (const float*)d_in[i];
    a.out = (float*)d_out; a.ws = (unsigned char*)d_ws;
    if (MK_N_LAUNCHES == 1) { a.ph_lo = 0; a.ph_hi = N_PHASES; hipLaunchKernelGGL(fwd_kernel, dim3(grid), dim3(NTHR), LDS_BYTES, stream, a); }
    else for (int p = 0; p < N_PHASES; ++p) {
        if (p == 1 || p == 1 + 9) continue;
        a.ph_lo = p; a.ph_hi = p + 1; hipLaunchKernelGGL(fwd_kernel, dim3(grid), dim3(NTHR), LDS_BYTES, stream, a);
    }
}
```

```cpp
#define MK_N_LAUNCHES 1

#include <hip/hip_runtime.h>
#include <cstdio>
#include <cstdint>

#ifndef MK_N_LAUNCHES
#define MK_N_LAUNCHES 1
#endif

#define LAS __attribute__((address_space(3)))
#define GAS __attribute__((address_space(1)))
typedef unsigned short bf16;
typedef short bf16x8 __attribute__((ext_vector_type(8)));
typedef float f32x4 __attribute__((ext_vector_type(4)));
typedef float f32x2 __attribute__((ext_vector_type(2)));
typedef unsigned u32x4 __attribute__((ext_vector_type(4)));
typedef unsigned u32x2 __attribute__((ext_vector_type(2)));
#define RLX_AGENT __ATOMIC_RELAXED, __HIP_MEMORY_SCOPE_AGENT
#define LDS_WAIT() asm volatile("s_waitcnt lgkmcnt(0)" ::: "memory")
#define VM_WAIT() asm volatile("s_waitcnt vmcnt(0)" ::: "memory")

constexpr int L = 16384, D = 1024, NWAVES = 8, NTHR = 512;
constexpr int PW = 6144;
constexpr int GW = 4096;
constexpr int YW = 2560;
constexpr int DFF = 2816, DFE = 3584, NE = 8;
constexpr int MAXSLOT = 34816;
constexpr float EPS = 1e-6f;

constexpr size_t MiB = 1u << 20;
constexpr size_t WS_CTL = 0, CTL_ZERO_BYTES = 1 * MiB;
constexpr size_t WS_SMALL = 1 * MiB;
constexpr size_t SM_GMW = 0, SM_POOLT = 256 * 1024, SM_WDT = 512 * 1024;
constexpr size_t WS_W1T = 2 * MiB;
constexpr size_t WS_BRT = 42 * MiB;
constexpr size_t WS_OUTT = 52 * MiB;
constexpr size_t WS_UPT = 56 * MiB;
constexpr size_t WS_DNT = 67 * MiB;
constexpr size_t WS_MOEDN = 2 * MiB;
constexpr size_t WS_XC = 74 * MiB;
constexpr size_t WS_R = 138 * MiB;
constexpr size_t WS_H = WS_R;
constexpr size_t WS_PROJ = WS_R + 32 * MiB;
constexpr size_t WS_YCAT = WS_R + 224 * MiB;
constexpr size_t WS_STATES = WS_R + 304 * MiB;
constexpr size_t WS_DACS = WS_R + 368 * MiB;
constexpr size_t WS_CC = WS_R + 369 * MiB;
constexpr size_t WS_GATES = WS_R + 32 * MiB;
constexpr size_t WS_MERGED = WS_R + 160 * MiB;
constexpr size_t WS_H2 = WS_R;
constexpr size_t WS_ACT = WS_R + 32 * MiB;
constexpr size_t WS_MOEUP = WS_R + 32 * MiB;
constexpr size_t WS_ROUTE = WS_R + 144 * MiB;
constexpr size_t RT_TOPK = 0, RT_CNT = 256 * 1024, RT_ROWIDX = 288 * 1024, RT_TOKSLOT = 448 * 1024, RT_TILEE = 640 * 1024, RT_NT = 644 * 1024;
constexpr size_t WS_ACTM = WS_R + 164 * MiB;
constexpr size_t WS_YBUF = WS_R + 32 * MiB;
constexpr size_t WS_END = 540 * MiB;
static_assert(WS_ACTM + (size_t)MAXSLOT * DFE <= WS_END, "ws map");
static_assert(WS_CC + (size_t)L * 512 * 2 <= WS_END, "ws map");
constexpr int CW_TMO = 0, CW_BAR = 4096;

constexpr int LDS_BYTES = 147456;
constexpr int MISC_OFF = LDS_BYTES - 256;
constexpr int WORK_BYTES = MISC_OFF;

typedef __bf16 bf16x2_t __attribute__((ext_vector_type(2)));
__device__ __forceinline__ unsigned cvt_pk_bf16(float lo, float hi) { const f32x2 v = {lo, hi}; const bf16x2_t r = __builtin_convertvector(v, bf16x2_t); return __builtin_bit_cast(unsigned, r); }
__device__ __forceinline__ unsigned cvt4_fp8(float a, float b, float c, float d) { unsigned r = 0; r = __builtin_amdgcn_cvt_pk_fp8_f32(a, b, r, false); r = __builtin_amdgcn_cvt_pk_fp8_f32(c, d, r, true); return r; }
constexpr float MOE_UP_WSCALE = 32.f, MOE_DN_WSCALE = 64.f;
__device__ __forceinline__ float bflo(unsigned u) { return __uint_as_float(u << 16); }
__device__ __forceinline__ float bfhi(unsigned u) { return __uint_as_float(u & 0xffff0000u); }
__device__ __forceinline__ float bf1(bf16 b) { return __uint_as_float(((unsigned)b) << 16); }
__device__ __forceinline__ bf16 f2bf(float f) { return (bf16)(cvt_pk_bf16(f, 0.f) & 0xffffu); }
__device__ __forceinline__ void unpack8(const u32x4 v, float (&o)[8]) { o[0] = bflo(v.x); o[1] = bfhi(v.x); o[2] = bflo(v.y); o[3] = bfhi(v.y); o[4] = bflo(v.z); o[5] = bfhi(v.z); o[6] = bflo(v.w); o[7] = bfhi(v.w); }
__device__ __forceinline__ u32x4 pack8(const float (&o)[8]) { u32x4 v; v.x = cvt_pk_bf16(o[0], o[1]); v.y = cvt_pk_bf16(o[2], o[3]); v.z = cvt_pk_bf16(o[4], o[5]); v.w = cvt_pk_bf16(o[6], o[7]); return v; }
__device__ __forceinline__ float fast_exp(float x) { return __builtin_amdgcn_exp2f(x * 1.4426950408889634f); }
__device__ __forceinline__ float fast_rcp(float x) { return __builtin_amdgcn_rcpf(x); }
__device__ __forceinline__ float sigmoid_f(float x) { return fast_rcp(1.f + fast_exp(-x)); }
__device__ __forceinline__ float silu_f(float x) { return x * sigmoid_f(x); }
__device__ __forceinline__ float gelu_tanh_f(float x) { const float u = 0.7978845608028654f * (x + 0.044715f * x * x * x); return x * sigmoid_f(2.f * u); }
__device__ __forceinline__ float softplus_f(float x) { return fmaxf(x, 0.f) + log1pf(expf(-fabsf(x))); }
__device__ __forceinline__ float wave_sum(float v) {
#pragma unroll
    for (int o = 1; o < 64; o <<= 1) v += __shfl_xor(v, o);
    return v;
}
#define MMA16(acc, q, p) (acc) = __builtin_amdgcn_mfma_f32_16x16x32_bf16((q), (p), (acc), 0, 0, 0)
__device__ __forceinline__ bf16x8 ldsfrag(LAS unsigned char* base, int byteoff) { return *(const LAS bf16x8*)(base + byteoff); }
__device__ __forceinline__ bf16x8 gfrag(const bf16* p) { return *(const bf16x8*)p; }
typedef short s16x4 __attribute__((ext_vector_type(4)));
__device__ __forceinline__ bf16x8 ldsfrag_tr(LAS unsigned char* base, int pitchB, int k0, int n0, int fr, int fq) {
    LAS unsigned char* p = base + (k0 + 8 * fq + (fr >> 2)) * pitchB + (n0 + 4 * (fr & 3)) * 2;
    const s16x4 a = __builtin_amdgcn_ds_read_tr16_b64_v4i16((LAS s16x4*)p), b = __builtin_amdgcn_ds_read_tr16_b64_v4i16((LAS s16x4*)(p + 4 * pitchB));
    return __builtin_shufflevector(a, b, 0, 1, 2, 3, 4, 5, 6, 7);
}

#define XB_TMO      128
#define XB_XCNT(j)  (256  + 64 * (j))
#define XB_XSUB(j)  (1280 + 64 * (j))
#define XB_XGEN(j)  (2304 + 64 * (j))
#define XB_TOP      3328
#define XB_TOPGEN   3392
#define XCD_BAR_WORDS 3456
#define XB_SPIN_CAP (1u << 18)
__device__ __forceinline__ unsigned xb_ld(unsigned* p)              { return __hip_atomic_load(p, __ATOMIC_RELAXED, __HIP_MEMORY_SCOPE_AGENT); }
__device__ __forceinline__ unsigned xb_add(unsigned* p, unsigned v) { return __hip_atomic_fetch_add(p, v, __ATOMIC_RELAXED, __HIP_MEMORY_SCOPE_AGENT); }
__device__ __forceinline__ unsigned xb_xcc_id() { return (unsigned)__builtin_amdgcn_s_getreg((3 << 11) | 20) & 0xFu; }
#define XB_SPIN(cond, bar) do { unsigned _sp = 0; while (cond) { __builtin_amdgcn_s_sleep(1); \
    if ((++_sp & 255u) == 0u) { if (xb_ld(&(bar)[XB_TMO])) break; if (_sp > XB_SPIN_CAP) { atomicAdd(&(bar)[XB_TMO], 1u); break; } } } } while (0)
struct XcdBarrier { unsigned* bar; unsigned x; volatile LAS unsigned* st; };
__device__ __forceinline__ XcdBarrier xcd_barrier_post(unsigned* bar, volatile LAS unsigned* st) {
    XcdBarrier b; b.bar = bar; b.x = xb_xcc_id(); b.st = st;
    if (threadIdx.x == 0) (void)xb_add(&bar[XB_XCNT(b.x)], 1u);
    return b;
}
__device__ __forceinline__ void xcd_barrier_complete(unsigned* bar, unsigned x, unsigned& nloc, unsigned& nx) {
    const unsigned G = gridDim.x * gridDim.y * gridDim.z;
    unsigned sum, cnt, mine, sp = 0u;
    for (;;) {
        sum = 0u; cnt = 0u; mine = 0u;
#pragma unroll
        for (unsigned j = 0; j < 16; ++j) { const unsigned c = xb_ld(&bar[XB_XCNT(j)]); sum += c; cnt += (c > 0u) ? 1u : 0u; mine = (j == x) ? c : mine; }
        if (sum == G) break;
        __builtin_amdgcn_s_sleep(1);
        if ((++sp & 255u) == 0u) { if (xb_ld(&bar[XB_TMO])) break; if (sp > XB_SPIN_CAP) { atomicAdd(&bar[XB_TMO], 1u); break; } }
    }
    nloc = mine > 0u ? mine : 1u; nx = cnt > 0u ? cnt : 1u;
}
__device__ __forceinline__ void xcd_barrier(const XcdBarrier& b) {
    asm volatile("s_waitcnt vmcnt(0)" ::: "memory");
    __syncthreads();
    if (threadIdx.x == 0) {
        unsigned* bar = b.bar;
        __builtin_amdgcn_s_waitcnt(0);
        unsigned nloc = b.st[0], nx = b.st[1];
        if (nloc == 0u) { xcd_barrier_complete(bar, b.x, nloc, nx); b.st[0] = nloc; b.st[1] = nx; }
        const unsigned old = xb_add(&bar[XB_XSUB(b.x)], 1u);
        const unsigned gen = old / nloc;
        if (old + 1u == (gen + 1u) * nloc) {
            __builtin_amdgcn_fence(__ATOMIC_RELEASE, "agent");
            asm volatile("s_waitcnt vmcnt(0)" ::: "memory");
            const unsigned og = xb_add(&bar[XB_TOP], 1u);
            const unsigned tg = og / nx;
            if (og + 1u == (tg + 1u) * nx) xb_add(&bar[XB_TOPGEN], 1u);
            else XB_SPIN(xb_ld(&bar[XB_TOPGEN]) == tg, bar);
            __builtin_amdgcn_fence(__ATOMIC_ACQUIRE, "agent");
            xb_add(&bar[XB_XGEN(b.x)], 1u);
            asm volatile("s_waitcnt vmcnt(0)" ::: "memory");
        } else {
            XB_SPIN(xb_ld(&bar[XB_XGEN(b.x)]) == gen, bar);
            __builtin_amdgcn_fence(__ATOMIC_ACQUIRE, "agent");
            asm volatile("s_waitcnt vmcnt(0)" ::: "memory");
        }
    }
    __syncthreads();
}
namespace pg8 {
constexpr int BM = 256, BK = 64, HALF = 128, HTB = HALF * BK * 2, STAGE_BYTES = 8 * HTB, NXCD = 8, WGM = 8;
__host__ __device__ __forceinline__ int lds_byte(int r, int c) { const int st = (r >> 4) * 2 + (c >> 5), rr = r & 15, cc = c & 31, ob = rr * 64 + cc * 2; return st * 1024 + (ob ^ (((ob >> 9) & 1) << 5)); }
__host__ __device__ __forceinline__ void stage_rc(int b, int& R, int& C) { const int st = b / 1024, sb = b % 1024, swz = sb ^ (((sb >> 9) & 1) << 5); R = (st >> 1) * 16 + swz / 64; C = (st & 1) * 32 + (swz % 64) / 2; }
__host__ __device__ __forceinline__ int perm32(int rho) { const int n = rho >> 4, i = rho & 15; return 8 * (i >> 2) + 4 * n + (i & 3); }

struct Unit { int pm, pn; const char* a; const char* b; };
struct TileOrder {
    int nM, nN, nwg, G, c;
    __device__ __forceinline__ void init(int nM_, int nN_, int G_, int c_) { nM = nM_; nN = nN_; nwg = nM * nN; G = G_; c = c_; }
    __device__ __forceinline__ bool tile(int i, int& pm, int& pn) const {
        const long Lq = (long)i * G + c; if (Lq >= nwg) return false;
        int wgid = (int)Lq; { const int q = nwg / NXCD, r = nwg % NXCD, xcd = wgid % NXCD, off = wgid / NXCD; wgid = (xcd < r ? xcd * (q + 1) : r * (q + 1) + (xcd - r) * q) + off; }
        const int nig = WGM * nN, gid = wgid / nig, fm = gid * WGM, gsz = (nM - fm) < WGM ? (nM - fm) : WGM;
        pm = fm + ((wgid % nig) % gsz); pn = (wgid % nig) / gsz; return true;
    }
};
struct DenseSched {
    TileOrder o; const char* A; const char* Bt; size_t tstep;
    __device__ __forceinline__ void init(const bf16* A_, const bf16* Bt_, int M, int N, int K, int G, int c) { o.init(M / BM, N / BM, G, c); A = (const char*)A_; Bt = (const char*)Bt_; tstep = (size_t)BM * K * 2; }
    __device__ __forceinline__ bool next(int i, Unit& u) const { if (!o.tile(i, u.pm, u.pn)) return false; u.a = A + (size_t)u.pm * tstep; u.b = Bt + (size_t)u.pn * tstep; return true; }
    __device__ __forceinline__ unsigned arow(const Unit&, int) const { return 0u; }
};

__device__ __forceinline__ unsigned cvt_pk(float lo, float hi) { return cvt_pk_bf16(lo, hi); }

struct EpiBf16Act {
    static constexpr bool PERM = true, HAS_MID = false;
    bf16* O; int ldc; int gelu_lo, gelu_hi; int sig;
    __device__ __forceinline__ void operator()(f32x4 (&acc)[2][2][4][2], const Unit& u, int wr, int wc, int fr, int fq) const {
        asm volatile("" : "+v"(fr), "+v"(fq));
        const int row0 = u.pm * BM + wr * 64 + fr, col0 = u.pn * BM + wc * 32 + 8 * fq;
        const int mode = sig ? 2 : ((u.pn >= gelu_lo && u.pn < gelu_hi) ? 1 : 0);
#pragma unroll
        for (int ai = 0; ai < 2; ++ai)
#pragma unroll
            for (int m = 0; m < 4; ++m) { bf16* rowp = O + (size_t)(row0 + ai * HALF + m * 16) * ldc + col0;
#pragma unroll
                for (int bj = 0; bj < 2; ++bj) { f32x4 v0 = acc[ai][bj][m][0], v1 = acc[ai][bj][m][1];
                    if (mode == 1) {
#pragma unroll
                        for (int j = 0; j < 4; ++j) { v0[j] = gelu_tanh_f(v0[j]); v1[j] = gelu_tanh_f(v1[j]); } }
                    else if (mode == 2) {
#pragma unroll
                        for (int j = 0; j < 4; ++j) { v0[j] = sigmoid_f(v0[j]); v1[j] = sigmoid_f(v1[j]); } }
                    u32x4 w; w.x = cvt_pk(v0[0], v0[1]); w.y = cvt_pk(v0[2], v0[3]); w.z = cvt_pk(v1[0], v1[1]); w.w = cvt_pk(v1[2], v1[3]);
                    *(u32x4*)(rowp + bj * HALF) = w; } }
    }
};
struct EpiSwiglu {
    static constexpr bool PERM = true, HAS_MID = false;
    bf16* O; int ldc;
    __device__ __forceinline__ void operator()(f32x4 (&acc)[2][2][4][2], const Unit& u, int wr, int wc, int fr, int fq) const {
        asm volatile("" : "+v"(fr), "+v"(fq));
        const int row0 = u.pm * BM + wr * 64 + fr, col0 = u.pn * HALF + wc * 32 + 8 * fq;
#pragma unroll
        for (int ai = 0; ai < 2; ++ai)
#pragma unroll
            for (int m = 0; m < 4; ++m) { bf16* rowp = O + (size_t)(row0 + ai * HALF + m * 16) * ldc + col0;
                f32x4 v0, v1;
#pragma unroll
                for (int j = 0; j < 4; ++j) { v0[j] = silu_f(acc[ai][0][m][0][j]) * acc[ai][1][m][0][j]; v1[j] = silu_f(acc[ai][0][m][1][j]) * acc[ai][1][m][1][j]; }
                u32x4 w; w.x = cvt_pk(v0[0], v0[1]); w.y = cvt_pk(v0[2], v0[3]); w.z = cvt_pk(v1[0], v1[1]); w.w = cvt_pk(v1[2], v1[3]);
                *(u32x4*)rowp = w; }
    }
};
struct EpiSwigluF8 {
    static constexpr bool PERM = true, HAS_MID = false;
    unsigned char* O; int ldc; float descale;
    __device__ __forceinline__ void operator()(f32x4 (&acc)[2][2][4][2], const Unit& u, int wr, int wc, int fr, int fq) const {
        asm volatile("" : "+v"(fr), "+v"(fq));
        const int row0 = u.pm * BM + wr * 64 + fr, col0 = u.pn * HALF + wc * 32 + 8 * fq;
#pragma unroll
        for (int ai = 0; ai < 2; ++ai)
#pragma unroll
            for (int m = 0; m < 4; ++m) { unsigned char* rowp = O + (size_t)(row0 + ai * HALF + m * 16) * ldc + col0;
                f32x4 v0, v1;
#pragma unroll
                for (int j = 0; j < 4; ++j) { v0[j] = silu_f(acc[ai][0][m][0][j] * descale) * (acc[ai][1][m][0][j] * descale); v1[j] = silu_f(acc[ai][0][m][1][j] * descale) * (acc[ai][1][m][1][j] * descale); }
                u32x2 w; w.x = cvt4_fp8(v0[0], v0[1], v0[2], v0[3]); w.y = cvt4_fp8(v1[0], v1[1], v1[2], v1[3]);
                *(u32x2*)rowp = w; }
    }
};
struct EpiBf16Scale {
    static constexpr bool PERM = true, HAS_MID = false;
    bf16* O; int ldc; float descale;
    __device__ __forceinline__ void operator()(f32x4 (&acc)[2][2][4][2], const Unit& u, int wr, int wc, int fr, int fq) const {
        asm volatile("" : "+v"(fr), "+v"(fq));
        const int row0 = u.pm * BM + wr * 64 + fr, col0 = u.pn * BM + wc * 32 + 8 * fq;
#pragma unroll
        for (int ai = 0; ai < 2; ++ai)
#pragma unroll
            for (int m = 0; m < 4; ++m) { bf16* rowp = O + (size_t)(row0 + ai * HALF + m * 16) * ldc + col0;
#pragma unroll
                for (int bj = 0; bj < 2; ++bj) { const f32x4 v0 = acc[ai][bj][m][0] * descale, v1 = acc[ai][bj][m][1] * descale;
                    u32x4 w; w.x = cvt_pk(v0[0], v0[1]); w.y = cvt_pk(v0[2], v0[3]); w.z = cvt_pk(v1[0], v1[1]); w.w = cvt_pk(v1[2], v1[3]);
                    *(u32x4*)(rowp + bj * HALF) = w; } }
    }
};
struct EpiResid {
    static constexpr bool PERM = false, HAS_MID = false;
    const float* R; float* O; int ldc;
    __device__ __forceinline__ void operator()(f32x4 (&acc)[2][2][4][2], const Unit& u, int wr, int wc, int fr, int fq) const {
        asm volatile("" : "+v"(fr), "+v"(fq));
        const int row0 = u.pm * BM + wr * 64 + fr, col0 = u.pn * BM + wc * 32 + 4 * fq;
#pragma unroll
        for (int ai = 0; ai < 2; ++ai)
#pragma unroll
            for (int m = 0; m < 4; ++m) { const size_t off = (size_t)(row0 + ai * HALF + m * 16) * ldc + col0;
#pragma unroll
                for (int bj = 0; bj < 2; ++bj)
#pragma unroll
                    for (int n = 0; n < 2; ++n) { const f32x4 r = *(const f32x4*)(R + off + bj * HALF + n * 16); *(f32x4*)(O + off + bj * HALF + n * 16) = r + acc[ai][bj][m][n]; }
                asm volatile("" ::: "memory"); }
    }
};
struct EpiResidScale {
    static constexpr bool PERM = false, HAS_MID = false;
    const float* R; float* O; int ldc; float descale;
    __device__ __forceinline__ void operator()(f32x4 (&acc)[2][2][4][2], const Unit& u, int wr, int wc, int fr, int fq) const {
        asm volatile("" : "+v"(fr), "+v"(fq));
        const int row0 = u.pm * BM + wr * 64 + fr, col0 = u.pn * BM + wc * 32 + 4 * fq;
#pragma unroll
        for (int ai = 0; ai < 2; ++ai)
#pragma unroll
            for (int m = 0; m < 4; ++m) { const size_t off = (size_t)(row0 + ai * HALF + m * 16) * ldc + col0;
#pragma unroll
                for (int bj = 0; bj < 2; ++bj)
#pragma unroll
                    for (int n = 0; n < 2; ++n) { const f32x4 r = *(const f32x4*)(R + off + bj * HALF + n * 16); *(f32x4*)(O + off + bj * HALF + n * 16) = r + acc[ai][bj][m][n] * descale; }
                asm volatile("" ::: "memory"); }
    }
};
struct EpiMerge {
    static constexpr bool PERM = true, HAS_MID = true;
    const bf16* Gt; bf16* O;
    __device__ __forceinline__ int mid_branch(int kdone) const { return kdone == 512 ? 1 : (kdone == 1536 ? 2 : (kdone == 2048 ? 3 : 0)); }
    __device__ __forceinline__ void mid(f32x4 (&acc)[2][2][4][2], const Unit& u, int nb, int wr, int wc, int fr, int fq) const {
        asm volatile("" : "+v"(fr), "+v"(fq));
        const int row0 = u.pm * BM + wr * 64 + fr, col0 = u.pn * BM + wc * 32 + 8 * fq;
#pragma unroll
        for (int ai = 0; ai < 2; ++ai)
#pragma unroll
            for (int m = 0; m < 4; ++m) { const unsigned go = (unsigned)(row0 + ai * HALF + m * 16) * (unsigned)GW + (unsigned)col0 + (unsigned)(nb - 1) * 1024u;
#pragma unroll
                for (int bj = 0; bj < 2; ++bj) { const u32x4 a = *(const u32x4*)(Gt + (go + bj * HALF)), b = *(const u32x4*)(Gt + (go + 1024u + bj * HALF));
                    float ga[8], gb[8]; unpack8(a, ga); unpack8(b, gb);
#pragma unroll
                    for (int j = 0; j < 4; ++j) { acc[ai][bj][m][0][j] *= ga[j] * fast_rcp(gb[j]); acc[ai][bj][m][1][j] *= ga[4 + j] * fast_rcp(gb[4 + j]); }
                    asm volatile("" : "+v"(acc[ai][bj][m][0]), "+v"(acc[ai][bj][m][1]) :: "memory"); } }
    }
    __device__ __forceinline__ void operator()(f32x4 (&acc)[2][2][4][2], const Unit& u, int wr, int wc, int fr, int fq) const {
        asm volatile("" : "+v"(fr), "+v"(fq));
        const int row0 = u.pm * BM + wr * 64 + fr, col0 = u.pn * BM + wc * 32 + 8 * fq;
#pragma unroll
        for (int ai = 0; ai < 2; ++ai)
#pragma unroll
            for (int m = 0; m < 4; ++m) { const unsigned r = (unsigned)(row0 + ai * HALF + m * 16);
#pragma unroll
                for (int bj = 0; bj < 2; ++bj) { const u32x4 g3 = *(const u32x4*)(Gt + (r * (unsigned)GW + 3072u + (unsigned)col0 + bj * HALF)); float g[8]; unpack8(g3, g);
                    const f32x4 v0 = acc[ai][bj][m][0], v1 = acc[ai][bj][m][1];
                    u32x4 w; w.x = cvt_pk(v0[0] * g[0], v0[1] * g[1]); w.y = cvt_pk(v0[2] * g[2], v0[3] * g[3]); w.z = cvt_pk(v1[0] * g[4], v1[1] * g[5]); w.w = cvt_pk(v1[2] * g[6], v1[3] * g[7]);
                    *(u32x4*)(O + (r * (unsigned)D + (unsigned)col0 + bj * HALF)) = w; }
                asm volatile("" ::: "memory"); }
    }
};

typedef int v8i __attribute__((ext_vector_type(8)));
typedef int u32x4i __attribute__((ext_vector_type(4)));
template <class Epi, class Sched, bool ALIGN_EPI, bool GATHER, int ESZ = 2>
__device__ __forceinline__ void gemm_phase(LAS unsigned char* lds, const int Kelem, const Sched& S, const Epi& E) {
    const int K = (ESZ == 2) ? Kelem : (Kelem >> 1);
    int tid_ = threadIdx.x; asm volatile("" : "+v"(tid_)); const int tid = tid_, wid = __builtin_amdgcn_readfirstlane(tid >> 6), lane = tid & 63, wr = wid >> 2, wc = wid & 3, fr = lane & 15, fq = lane >> 4;
    const int nt = K / BK;
    unsigned voffB[2], aoC[2][2], aoN[2][2];
#pragma unroll
    for (int i = 0; i < 2; ++i) { int R, C; stage_rc(tid * 16 + i * 8192, R, C); const int Rb = Epi::PERM ? ((R & ~31) + perm32(R & 31)) : R;
        voffB[i] = (unsigned)(Rb * K + C) * 2u;
#pragma unroll
        for (int h = 0; h < 2; ++h) { aoC[h][i] = (unsigned)((R + h * HALF) * K + C) * 2u; aoN[h][i] = aoC[h][i]; } }
    const size_t kstep = (size_t)(BK * 2);
    const size_t hstep = (size_t)HALF * K * 2;
    const size_t pstep = (size_t)64 * K * 2;
    const unsigned ldsw = (unsigned)wid * 1024u;
    const int aoff = lds_byte(wr * 64 + fr, fq * 8), boff = lds_byte(wc * 32 + fr, fq * 8);
#define PG8_SA(b, h) (((b) * 2 + (h)) * HTB)
#define PG8_SB(b, h) ((4 + (b) * 2 + (h)) * HTB)
#define PG8_STAGE(bufoff, gbase, voff) do { const char* _sb = (const char*)(gbase); asm volatile("" : "+s"(_sb)); _Pragma("unroll") for (int _i = 0; _i < 2; ++_i) \
        __builtin_amdgcn_global_load_lds((const unsigned*)(_sb + (voff)[_i]), (LAS unsigned*)(lds + (bufoff) + ldsw + _i * 8192), 16, 0, 0); } while (0)
#define PG8_STAGE1(bufoff, gbase, voff0) do { _Pragma("unroll") for (int _i = 0; _i < 2; ++_i) { const char* _sb = (const char*)(gbase) + (size_t)_i * pstep; asm volatile("" : "+s"(_sb)); \
        __builtin_amdgcn_global_load_lds((const unsigned*)(_sb + (voff0)), (LAS unsigned*)(lds + (bufoff) + ldsw + _i * 8192), 16, 0, 0); } } while (0)
#define PG8_STAGE_AC(bufoff, gbase, h) do { if constexpr (GATHER) PG8_STAGE(bufoff, gbase, aoC[h]); else PG8_STAGE1(bufoff, (const char*)(gbase) + (size_t)(h) * hstep, aoC[0][0]); } while (0)
#define PG8_STAGE_A2(bufoff, gbase, h) do { if constexpr (GATHER) { if (last) PG8_STAGE(bufoff, gbase, aoN[h]); else PG8_STAGE(bufoff, gbase, aoC[h]); } else PG8_STAGE1(bufoff, (const char*)(gbase) + (size_t)(h) * hstep, aoC[0][0]); } while (0)
#define PG8_LDA(dst, b, h) do { _Pragma("unroll") for (int m = 0; m < 4; ++m) _Pragma("unroll") for (int k = 0; k < 2; ++k) dst[m][k] = *(const LAS bf16x8*)(lds + PG8_SA(b, h) + aoff + m * 2048 + k * 1024); } while (0)
#define PG8_LDB(dst, b, h) do { _Pragma("unroll") for (int n = 0; n < 2; ++n) _Pragma("unroll") for (int k = 0; k < 2; ++k) dst[n][k] = *(const LAS bf16x8*)(lds + PG8_SB(b, h) + boff + n * 2048 + k * 1024); } while (0)
#define PG8_MMA(ai, bj, At, Bt) do { __builtin_amdgcn_s_setprio(1); _Pragma("unroll") for (int m = 0; m < 4; ++m) _Pragma("unroll") for (int n = 0; n < 2; ++n) _Pragma("unroll") for (int k = 0; k < 2; ++k) \
        acc[ai][bj][m][n] = __builtin_amdgcn_mfma_f32_16x16x32_bf16(Bt[n][k], At[m][k], acc[ai][bj][m][n], 0, 0, 0); __builtin_amdgcn_s_setprio(0); } while (0)
#define PG8_MMA8(ai, bj, A8, B8) do { __builtin_amdgcn_s_setprio(1); _Pragma("unroll") for (int m = 0; m < 4; ++m) _Pragma("unroll") for (int n = 0; n < 2; ++n) \
        acc[ai][bj][m][n] = __builtin_amdgcn_mfma_scale_f32_16x16x128_f8f6f4(B8[n], A8[m], acc[ai][bj][m][n], 0, 0, 0, one_scale, 0, one_scale); \
        asm volatile("" : "+v"(acc[ai][bj][0][0]), "+v"(acc[ai][bj][0][1]), "+v"(acc[ai][bj][1][0]), "+v"(acc[ai][bj][1][1]), "+v"(acc[ai][bj][2][0]), "+v"(acc[ai][bj][2][1]), "+v"(acc[ai][bj][3][0]), "+v"(acc[ai][bj][3][1])); \
        __builtin_amdgcn_s_setprio(0); } while (0)
#define PG8_LDA8(dst, b, h) do { _Pragma("unroll") for (int m = 0; m < 4; ++m) dst[m] = __builtin_shufflevector(*(const LAS u32x4i*)(lds + PG8_SA(b, h) + aoff + m * 2048), *(const LAS u32x4i*)(lds + PG8_SA(b, h) + aoff + m * 2048 + 1024), 0, 1, 2, 3, 4, 5, 6, 7); } while (0)
#define PG8_LDB8(dst, b, h) do { _Pragma("unroll") for (int n = 0; n < 2; ++n) dst[n] = __builtin_shufflevector(*(const LAS u32x4i*)(lds + PG8_SB(b, h) + boff + n * 2048), *(const LAS u32x4i*)(lds + PG8_SB(b, h) + boff + n * 2048 + 1024), 0, 1, 2, 3, 4, 5, 6, 7); } while (0)
#define PG8_MM(ai, bj, At, Bt) do { if constexpr (ESZ == 2) PG8_MMA(ai, bj, At, Bt); else PG8_MMA8(ai, bj, At##8, Bt##8); } while (0)
#define PG8_LA(dst, b, h) do { if constexpr (ESZ == 2) PG8_LDA(dst, b, h); else PG8_LDA8(dst##8, b, h); } while (0)
#define PG8_LB(dst, b, h) do { if constexpr (ESZ == 2) PG8_LDB(dst, b, h); else PG8_LDB8(dst##8, b, h); } while (0)
#define PG8_WAIT_V(n) asm volatile("s_waitcnt vmcnt(" #n ")" ::: "memory")
#define PG8_WAIT_L(n) asm volatile("s_waitcnt lgkmcnt(" #n ")" ::: "memory")
#define PG8_BAR __builtin_amdgcn_s_barrier()
#define PG8_SCHED __builtin_amdgcn_sched_barrier(0)
    int one_scale = 0x7f7f7f7f; asm volatile("" : "+v"(one_scale));
    Unit cur, nxt; int ui = 0;
    if (!S.next(0, cur)) return;
    if constexpr (GATHER) {
#pragma unroll
        for (int h = 0; h < 2; ++h)
#pragma unroll
            for (int i = 0; i < 2; ++i) { int R, C; stage_rc(tid * 16 + i * 8192, R, C); aoC[h][i] = (S.arow(cur, h * HALF + R) * (unsigned)K + (unsigned)C) * 2u; }
    }
    f32x4 acc[2][2][4][2];
#pragma unroll
    for (int a = 0; a < 2; ++a)
#pragma unroll
        for (int b = 0; b < 2; ++b)
#pragma unroll
            for (int m = 0; m < 4; ++m)
#pragma unroll
                for (int n = 0; n < 2; ++n) acc[a][b][m][n] = (f32x4){0.f, 0.f, 0.f, 0.f};
    bf16x8 At[4][2], B0[2][2], B1[2][2]; v8i At8[4], B08[2], B18[2];
    const char* cA = cur.a; const char* cB = cur.b;
    PG8_STAGE1(PG8_SB(0, 0), cB, voffB[0]); PG8_STAGE1(PG8_SB(0, 1), cB + hstep, voffB[0]); PG8_STAGE_AC(PG8_SA(0, 0), cA, 0); PG8_STAGE_AC(PG8_SA(0, 1), cA, 1);
    if (wr == 1) PG8_BAR;
    PG8_WAIT_V(2); PG8_BAR;
    PG8_STAGE1(PG8_SB(1, 0), cB + kstep, voffB[0]); PG8_STAGE_AC(PG8_SA(1, 0), cA + kstep, 0); PG8_STAGE1(PG8_SB(1, 1), cB + hstep + kstep, voffB[0]);
    PG8_WAIT_V(6); PG8_BAR;
    for (;;) {
        const bool has_next = S.next(ui + 1, nxt);
        const char* nA = has_next ? nxt.a : cA; const char* nB = has_next ? nxt.b : cB;
        if constexpr (GATHER) {
#pragma unroll
            for (int h = 0; h < 2; ++h)
#pragma unroll
                for (int i = 0; i < 2; ++i) { int R, C; stage_rc(tid * 16 + i * 8192, R, C); aoN[h][i] = has_next ? (S.arow(nxt, h * HALF + R) * (unsigned)K + (unsigned)C) * 2u : aoC[h][i]; }
        }
        for (int t = 0; t < nt; t += 2) {
            const bool last = (t == nt - 2);
            const char* a1 = cA + (size_t)(t + 1) * kstep;
            const char* a2 = last ? nA : cA + (size_t)(t + 2) * kstep; const char* b2 = last ? nB : cB + (size_t)(t + 2) * kstep;
            const char* a3 = a2 + kstep; const char* b3 = b2 + kstep;
            PG8_LB(B0, 0, 0); PG8_LB(B1, 0, 1); PG8_SCHED; PG8_LA(At, 0, 0); PG8_STAGE_AC(PG8_SA(1, 1), a1, 1);
            PG8_WAIT_V(8); PG8_WAIT_L(0); PG8_BAR; PG8_MM(0, 0, At, B0); PG8_MM(0, 1, At, B1); PG8_BAR; PG8_SCHED;
            PG8_LA(At, 0, 1); PG8_STAGE1(PG8_SB(0, 0), b2, voffB[0]); PG8_STAGE1(PG8_SB(0, 1), b2 + hstep, voffB[0]); PG8_STAGE_A2(PG8_SA(0, 0), a2, 0);
            PG8_WAIT_V(8); PG8_WAIT_L(0); PG8_BAR; PG8_MM(1, 0, At, B0); PG8_MM(1, 1, At, B1); PG8_BAR; PG8_SCHED;
            PG8_LB(B0, 1, 0); PG8_LB(B1, 1, 1); PG8_SCHED; PG8_LA(At, 1, 0); PG8_STAGE_A2(PG8_SA(0, 1), a2, 1);
            PG8_WAIT_V(8); PG8_WAIT_L(0); PG8_BAR; PG8_MM(0, 0, At, B0); PG8_MM(0, 1, At, B1); PG8_BAR; PG8_SCHED;
            PG8_LA(At, 1, 1); PG8_STAGE1(PG8_SB(1, 0), b3, voffB[0]); PG8_STAGE1(PG8_SB(1, 1), b3 + hstep, voffB[0]); PG8_STAGE_A2(PG8_SA(1, 0), a3, 0);
            PG8_WAIT_V(8); PG8_WAIT_L(0); PG8_BAR; PG8_MM(1, 0, At, B0); PG8_MM(1, 1, At, B1); PG8_BAR; PG8_SCHED;
            if constexpr (Epi::HAS_MID) { const int nb = E.mid_branch((t + 2) * BK); if (nb) { PG8_SCHED; E.mid(acc, cur, nb, wr, wc, fr, fq); PG8_SCHED; } }
        }
        if constexpr (ALIGN_EPI) { if (wr == 0) PG8_BAR; }
        E(acc, cur, wr, wc, fr, fq);
        if (!has_next) break;
#pragma unroll
        for (int a = 0; a < 2; ++a)
#pragma unroll
            for (int b = 0; b < 2; ++b)
#pragma unroll
                for (int m = 0; m < 4; ++m)
#pragma unroll
                    for (int n = 0; n < 2; ++n) acc[a][b][m][n] = (f32x4){0.f, 0.f, 0.f, 0.f};
        cur = nxt; cA = nA; cB = nB; ++ui;
        if constexpr (GATHER) {
#pragma unroll
            for (int h = 0; h < 2; ++h)
#pragma unroll
                for (int i = 0; i < 2; ++i) aoC[h][i] = aoN[h][i];
        }
        if constexpr (ALIGN_EPI) { if (wr == 1) PG8_BAR; }
    }
    PG8_WAIT_V(0);
    if constexpr (!ALIGN_EPI) { if (wr == 0) PG8_BAR; }
    PG8_BAR;
#undef PG8_SA
#undef PG8_SB
#undef PG8_STAGE
#undef PG8_STAGE1
#undef PG8_STAGE_A2
#undef PG8_STAGE_AC
#undef PG8_LDA
#undef PG8_LDB
#undef PG8_MMA
#undef PG8_MMA8
#undef PG8_MM
#undef PG8_LDA8
#undef PG8_LDB8
#undef PG8_LA
#undef PG8_LB
#undef PG8_WAIT_V
#undef PG8_WAIT_L
#undef PG8_BAR
#undef PG8_SCHED
}
}
struct Frame {
    LAS unsigned char* lds;
    volatile LAS unsigned* MISC;
    unsigned* ctl;
    unsigned char* ws;
    const float* const* in;
    float* out;
    int tid, lane, wave, G, bid;
};
#define WSP(T, off) ((T*)(F.ws + (off)))

__device__ __forceinline__ void tr_item(const float* src, int ldsrc, bf16* dst, int ldd, LAS float* scr, int lane) {
    const int kr = lane >> 3, n4 = 4 * (lane & 7);
    f32x4 v[8];
#pragma unroll
    for (int i = 0; i < 8; ++i) v[i] = *(const f32x4*)(src + (size_t)(8 * i + kr) * ldsrc + n4);
#pragma unroll
    for (int i = 0; i < 8; ++i) { LAS float* d = scr + (8 * i + kr) * 33 + n4; d[0] = v[i].x; d[1] = v[i].y; d[2] = v[i].z; d[3] = v[i].w; }
    LDS_WAIT(); asm volatile("" ::: "memory");
    const int c = lane & 7;
#pragma unroll
    for (int j = 0; j < 4; ++j) { const int n = (lane >> 3) + 8 * j; const LAS float* s = scr + (8 * c) * 33 + n;
        u32x4 o; o.x = cvt_pk_bf16(s[0 * 33], s[1 * 33]); o.y = cvt_pk_bf16(s[2 * 33], s[3 * 33]); o.z = cvt_pk_bf16(s[4 * 33], s[5 * 33]); o.w = cvt_pk_bf16(s[6 * 33], s[7 * 33]);
        *(u32x4*)(dst + (size_t)n * ldd + 8 * c) = o; }
    LDS_WAIT(); asm volatile("" ::: "memory");
}
__device__ __forceinline__ void tr_item_f8(const float* src, int ldsrc, unsigned char* dst, int ldd, float scale, LAS float* scr, int lane) {
    const int kr = lane >> 3, n4 = 4 * (lane & 7);
    f32x4 v[16];
#pragma unroll
    for (int i = 0; i < 16; ++i) v[i] = *(const f32x4*)(src + (size_t)(8 * i + kr) * ldsrc + n4);
#pragma unroll
    for (int i = 0; i < 16; ++i) { LAS float* d = scr + (8 * i + kr) * 33 + n4; d[0] = v[i].x * scale; d[1] = v[i].y * scale; d[2] = v[i].z * scale; d[3] = v[i].w * scale; }
    LDS_WAIT(); asm volatile("" ::: "memory");
    const int c = lane & 7;
#pragma unroll
    for (int j = 0; j < 4; ++j) { const int n = (lane >> 3) + 8 * j; const LAS float* s = scr + (16 * c) * 33 + n;
        u32x4 o; o.x = cvt4_fp8(s[0 * 33], s[1 * 33], s[2 * 33], s[3 * 33]); o.y = cvt4_fp8(s[4 * 33], s[5 * 33], s[6 * 33], s[7 * 33]);
        o.z = cvt4_fp8(s[8 * 33], s[9 * 33], s[10 * 33], s[11 * 33]); o.w = cvt4_fp8(s[12 * 33], s[13 * 33], s[14 * 33], s[15 * 33]);
        *(u32x4*)(dst + (size_t)n * ldd + 16 * c) = o; }
    LDS_WAIT(); asm volatile("" ::: "memory");
}
__device__ __forceinline__ void tr_job_item(const float* src, int ldsrc, int sc0, int K, int N, bf16* dst, int ldd, int dr0, int dk0, int it, LAS float* scr, int lane) {
    const int nblk = N / 32, kb = it / nblk, nb = it % nblk;
    tr_item(src + (size_t)(64 * kb) * ldsrc + sc0 + 32 * nb, ldsrc, dst + (size_t)(dr0 + 32 * nb) * ldd + dk0 + 64 * kb, ldd, scr, lane);
}
__device__ __forceinline__ void tr_up_item(const float* wg, const float* wu, int FF, bf16* dst, int it, LAS float* scr, int lane) {
    const int nblk = 2 * FF / 32, kb = it / nblk, nb = it % nblk, r0 = 32 * nb, pn = r0 >> 8, s = (r0 >> 7) & 1, j = r0 & 127;
    const float* src = (s ? wu : wg) + (size_t)(64 * kb) * FF + 128 * pn + j;
    tr_item(src, FF, dst + (size_t)r0 * D + 64 * kb, D, scr, lane);
}
__device__ __forceinline__ void convert_layer_weights(Frame& F, int l, int gw, int NGW) {
    LAS float* scr = (LAS float*)(F.lds + F.wave * 16896);
    const float* w_in = F.in[2] + (size_t)l * D * 6160; const float* w_gate = F.in[3] + (size_t)l * D * 4096;
    bf16* W1T = WSP(bf16, WS_W1T) + (size_t)l * 10240 * D; bf16* BRT = WSP(bf16, WS_BRT) + (size_t)l * D * YW; bf16* OUTT = WSP(bf16, WS_OUTT) + (size_t)l * D * D;
    constexpr int I_A = 16 * (4608 / 32), I_B = 16 * (1536 / 32), I_G = 16 * (4096 / 32);
    constexpr int I_BA = 8 * 32, I_BB = 16 * 32, I_BC = 8 * 32, I_BD = 8 * 32, I_O = 16 * 32;
    constexpr int NIT = I_A + I_B + I_G + I_BA + I_BB + I_BC + I_BD + I_O;
    for (int it = gw; it < NIT; it += NGW) {
        int r = it;
        if (r < I_A) { tr_job_item(w_in, 6160, 0, D, 4608, W1T, D, 0, 0, r, scr, F.lane); continue; } r -= I_A;
        if (r < I_B) { tr_job_item(w_in, 6160, 4624, D, 1536, W1T, D, 4608, 0, r, scr, F.lane); continue; } r -= I_B;
        if (r < I_G) { tr_job_item(w_gate, 4096, 0, D, 4096, W1T, D, 6144, 0, r, scr, F.lane); continue; } r -= I_G;
        if (r < I_BA) { tr_job_item(F.in[17] + (size_t)l * 512 * D, D, 0, 512, D, BRT, YW, 0, 0, r, scr, F.lane); continue; } r -= I_BA;
        if (r < I_BB) { tr_job_item(F.in[18] + (size_t)l * 1024 * D, D, 0, 1024, D, BRT, YW, 0, 512, r, scr, F.lane); continue; } r -= I_BB;
        if (r < I_BC) { tr_job_item(F.in[19] + (size_t)l * 512 * D, D, 0, 512, D, BRT, YW, 0, 1536, r, scr, F.lane); continue; } r -= I_BC;
        if (r < I_BD) { tr_job_item(F.in[20] + (size_t)l * 512 * D, D, 0, 512, D, BRT, YW, 0, 2048, r, scr, F.lane); continue; } r -= I_BD;
        tr_job_item(F.in[21] + (size_t)l * D * D, D, 0, D, D, OUTT, D, 0, 0, r, scr, F.lane);
    }
    for (int it = gw; it < 4 * 8; it += NGW) { const int g = it >> 3, r = it & 7;
        tr_job_item(F.in[15] + ((size_t)l * 4 + g) * 128 * 128, 128, 0, 128, 128, WSP(bf16, WS_SMALL + SM_POOLT) + ((size_t)l * 4 + g) * 128 * 128, 128, 0, 0, r, scr, F.lane); }
    const int gt = gw * 64 + F.lane, NGT = NGW * 64;
    for (int i = gt; i < 4 * 128 * 128; i += NGT) { const int s = i & 127, t = (i >> 7) & 127; const float v = F.in[13][(size_t)l * 65536 + i];
        WSP(bf16, WS_SMALL + SM_GMW)[(size_t)l * 65536 + i] = f2bf(s <= t ? v : 0.f); }
    for (int i = gt; i < 16 * 1024; i += NGT) { const int k = i >> 4, j = i & 15; WSP(bf16, WS_SMALL + SM_WDT)[(size_t)l * 16384 + j * 1024 + k] = f2bf(w_in[(size_t)k * 6160 + 4608 + j]); }
}
__device__ __forceinline__ void convert_ffn_weights(Frame& F, int gw, int NGW) {
    LAS float* scr = (LAS float*)(F.lds + F.wave * 16896);
    constexpr int I_U = 16 * (2 * DFF / 32), I_D = (DFF / 64) * (D / 32);
    for (int it = gw; it < I_U + I_D; it += NGW) {
        if (it < I_U) tr_up_item(F.in[23], F.in[24], DFF, WSP(bf16, WS_UPT), it, scr, F.lane);
        else tr_job_item(F.in[25], D, 0, DFF, D, WSP(bf16, WS_DNT), DFF, 0, 0, it - I_U, scr, F.lane);
    }
}
__device__ __forceinline__ void convert_moe_weights(Frame& F, int gw, int NGW) {
    LAS float* scr = (LAS float*)(F.lds + F.wave * 16896);
    constexpr int NB_U = 2 * DFE / 32, I_U = (D / 128) * NB_U, NB_D = D / 32, I_D = (DFE / 128) * NB_D;
    for (int it = gw; it < NE * (I_U + I_D); it += NGW) {
        const int e = it / (I_U + I_D), r = it % (I_U + I_D);
        if (r < I_U) { const int kb = r / NB_U, nb = r % NB_U, r0 = 32 * nb, pn = r0 >> 8, sel = (r0 >> 7) & 1, j = r0 & 127;
            const float* src = (sel ? F.in[28] : F.in[27]) + (size_t)e * D * DFE + (size_t)(128 * kb) * DFE + 128 * pn + j;
            tr_item_f8(src, DFE, WSP(unsigned char, WS_MOEUP) + (size_t)e * 2 * DFE * D + (size_t)r0 * D + 128 * kb, D, MOE_UP_WSCALE, scr, F.lane); }
        else { const int q = r - I_U, kb = q / NB_D, nb = q % NB_D;
            const float* src = F.in[29] + (size_t)e * DFE * D + (size_t)(128 * kb) * D + 32 * nb;
            tr_item_f8(src, D, WSP(unsigned char, WS_MOEDN) + (size_t)e * D * DFE + (size_t)(32 * nb) * DFE + 128 * kb, DFE, MOE_DN_WSCALE, scr, F.lane); }
    }
}

__device__ __forceinline__ void rms_row(const float* xrow, const float* g, bf16* orow, int lane, f32x4 (&v)[4]) {
    const f32x4* xr = (const f32x4*)xrow + lane;
    float s = 0.f;
#pragma unroll
    for (int j = 0; j < 4; ++j) { v[j] = xr[64 * j]; s += (v[j].x * v[j].x + v[j].y * v[j].y) + (v[j].z * v[j].z + v[j].w * v[j].w); }
    const float r = 1.0f / sqrtf(wave_sum(s) * (1.f / D) + EPS);
    u32x2* o8 = (u32x2*)orow + lane;
#pragma unroll
    for (int j = 0; j < 4; ++j) { const f32x4 gv = ((const f32x4*)g)[64 * j + lane]; v[j] = v[j] * r * gv; u32x2 w; w.x = cvt_pk_bf16(v[j].x, v[j].y); w.y = cvt_pk_bf16(v[j].z, v[j].w); o8[64 * j] = w; }
}
__device__ __forceinline__ void rms_row_f8(const float* xrow, const float* g, unsigned char* orow, int lane, f32x4 (&v)[4]) {
    const f32x4* xr = (const f32x4*)xrow + lane;
    float s = 0.f;
#pragma unroll
    for (int j = 0; j < 4; ++j) { v[j] = xr[64 * j]; s += (v[j].x * v[j].x + v[j].y * v[j].y) + (v[j].z * v[j].z + v[j].w * v[j].w); }
    const float r = 1.0f / sqrtf(wave_sum(s) * (1.f / D) + EPS);
    unsigned* o4 = (unsigned*)orow + lane;
#pragma unroll
    for (int j = 0; j < 4; ++j) { const f32x4 gv = ((const f32x4*)g)[64 * j + lane]; v[j] = v[j] * r * gv; o4[64 * j] = cvt4_fp8(v[j].x, v[j].y, v[j].z, v[j].w); }
}
__device__ __forceinline__ void rmsnorm_phase(Frame& F, const float* x, const float* g, bf16* out) {
    const int gw = F.bid * NWAVES + F.wave, NGW = F.G * NWAVES;
    for (int m = gw; m < L; m += NGW) { f32x4 v[4]; rms_row(x + (size_t)m * D, g, out + (size_t)m * D, F.lane, v); }
}

__device__ __forceinline__ void rmsnorm_phase_f8(Frame& F, const float* x, const float* g, unsigned char* out) {
    const int gw = F.bid * NWAVES + F.wave, NGW = F.G * NWAVES;
    for (int m = gw; m < L; m += NGW) { f32x4 v[4]; rms_row_f8(x + (size_t)m * D, g, out + (size_t)m * D, F.lane, v); }
}
__device__ __forceinline__ void route_phase(Frame& F, const float* x, const float* g, unsigned char* out, const float* rw) {
    LAS float* RW = (LAS float*)F.lds;
    LAS int* HC = (LAS int*)(F.lds + 32768);
    for (int i = F.tid; i < 8192; i += NTHR) RW[i] = rw[i];
    if (F.tid < 8) HC[F.tid] = 0;
    __syncthreads();
    unsigned* topk = WSP(unsigned, WS_ROUTE + RT_TOPK);
    for (int rr = 0; rr < 8; ++rr) {
        const int t = F.bid * 64 + F.wave * 8 + rr;
        f32x4 v[4]; rms_row_f8(x + (size_t)t * D, g, out + (size_t)t * D, F.lane, v);
        float lg[8];
#pragma unroll
        for (int e = 0; e < 8; ++e) lg[e] = 0.f;
#pragma unroll
        for (int j = 0; j < 4; ++j)
#pragma unroll
            for (int q = 0; q < 4; ++q) { const int k = 4 * (64 * j + F.lane) + q; const f32x4 w0 = *(const LAS f32x4*)(RW + k * 8), w1 = *(const LAS f32x4*)(RW + k * 8 + 4); const float xv = v[j][q];
                lg[0] += xv * w0.x; lg[1] += xv * w0.y; lg[2] += xv * w0.z; lg[3] += xv * w0.w; lg[4] += xv * w1.x; lg[5] += xv * w1.y; lg[6] += xv * w1.z; lg[7] += xv * w1.w; }
#pragma unroll
        for (int e = 0; e < 8; ++e) lg[e] = wave_sum(lg[e]);
        int i0 = 0; float m0 = lg[0];
#pragma unroll
        for (int e = 1; e < 8; ++e) if (lg[e] > m0) { m0 = lg[e]; i0 = e; }
        int i1 = -1; float m1 = -3.0e38f;
#pragma unroll
        for (int e = 0; e < 8; ++e) if (e != i0 && lg[e] > m1) { m1 = lg[e]; i1 = e; }
        const float e1 = expf(m1 - m0), den = 1.f + e1;
        if (F.lane == 0) { u32x4 o; o.x = (unsigned)i0; o.y = (unsigned)i1; o.z = __float_as_uint(1.f / den); o.w = __float_as_uint(e1 / den); *(u32x4*)(topk + 4 * t) = o;
            atomicAdd((int*)&HC[i0], 1); atomicAdd((int*)&HC[i1], 1); }
    }
    __syncthreads();
    if (F.tid < 8) WSP(int, WS_ROUTE + RT_CNT)[F.bid * 8 + F.tid] = HC[F.tid];
}
__device__ __forceinline__ void assign_phase(Frame& F) {
    LAS int* SB = (LAS int*)F.lds;
    const int* cnt = WSP(int, WS_ROUTE + RT_CNT);
    const unsigned* topk = WSP(unsigned, WS_ROUTE + RT_TOPK);
    int* rowidx = WSP(int, WS_ROUTE + RT_ROWIDX); int* tokslot = WSP(int, WS_ROUTE + RT_TOKSLOT);
    if (F.tid < 8) { int before = 0, tot = 0; for (int b = 0; b < F.G; ++b) { const int c = cnt[b * 8 + F.tid]; tot += c; if (b < F.bid) before += c; } SB[F.tid] = before; SB[16 + F.tid] = tot; }
    __syncthreads();
    if (F.tid == 0) { int off = 0; for (int e = 0; e < 8; ++e) { SB[8 + e] = off; off += (SB[16 + e] + 255) & ~255; } SB[24] = off; }
    __syncthreads();
    if (F.tid < 8) { const int e = F.tid; int run = SB[8 + e] + SB[e];
        for (int i = 0; i < 64; ++i) { const int t = F.bid * 64 + i; const unsigned e0 = topk[4 * t], e1 = topk[4 * t + 1];
            if ((int)e0 == e) { rowidx[run] = t; tokslot[2 * t] = run; ++run; }
            if ((int)e1 == e) { rowidx[run] = t; tokslot[2 * t + 1] = run; ++run; } } }
    if (F.bid < 8) { const int e = F.bid, lo = SB[8 + e] + SB[16 + e], hi = SB[8 + e] + ((SB[16 + e] + 255) & ~255); for (int s = lo + F.tid; s < hi; s += NTHR) rowidx[s] = 0; }
    if (F.bid == 0) { int* tile_e = WSP(int, WS_ROUTE + RT_TILEE); const int nt = SB[24] >> 8;
        for (int i = F.tid; i < nt; i += NTHR) { int e = 0; for (int q = 1; q < 8; ++q) if (i * 256 >= SB[8 + q]) e = q; tile_e[i] = e; }
        if (F.tid == 0) WSP(int, WS_ROUTE + RT_NT)[0] = nt; }
}
struct MoeUpSched {
    pg8::TileOrder o; const char* A; const char* Bt; const int* tile_e; const int* rowidx;
    __device__ __forceinline__ bool next(int i, pg8::Unit& u) const { if (!o.tile(i, u.pm, u.pn)) return false; const int e = __builtin_amdgcn_readfirstlane(tile_e[u.pm]); u.a = A; u.b = Bt + ((size_t)e * 2 * DFE + (size_t)u.pn * 256) * D; return true; }
    __device__ __forceinline__ unsigned arow(const pg8::Unit& u, int r) const { return (unsigned)rowidx[u.pm * 256 + r]; }
};
struct MoeDnSched {
    pg8::TileOrder o; const char* A; const char* Bt; const int* tile_e;
    __device__ __forceinline__ bool next(int i, pg8::Unit& u) const { if (!o.tile(i, u.pm, u.pn)) return false; const int e = __builtin_amdgcn_readfirstlane(tile_e[u.pm]); u.a = A + (size_t)u.pm * 256 * DFE; u.b = Bt + ((size_t)e * D + (size_t)u.pn * 256) * DFE; return true; }
    __device__ __forceinline__ unsigned arow(const pg8::Unit&, int) const { return 0u; }
};
__device__ __forceinline__ void final_phase(Frame& F, const float* x, const bf16* ybuf, const float* g, float* out) {
    const int gw = F.bid * NWAVES + F.wave, NGW = F.G * NWAVES;
    const unsigned* topk = WSP(unsigned, WS_ROUTE + RT_TOPK); const int* tokslot = WSP(int, WS_ROUTE + RT_TOKSLOT);
    for (int t = gw; t < L; t += NGW) {
        const float g0 = __uint_as_float(topk[4 * t + 2]), g1 = __uint_as_float(topk[4 * t + 3]); const int s0 = tokslot[2 * t], s1 = tokslot[2 * t + 1];
        const f32x4* xr = (const f32x4*)(x + (size_t)t * D) + F.lane; const u32x2* y0 = (const u32x2*)(ybuf + (size_t)s0 * D) + F.lane; const u32x2* y1 = (const u32x2*)(ybuf + (size_t)s1 * D) + F.lane;
        f32x4 v[4]; float s = 0.f;
#pragma unroll
        for (int j = 0; j < 4; ++j) { const u32x2 a = y0[64 * j], b = y1[64 * j]; v[j] = xr[64 * j];
            v[j].x += g0 * bflo(a.x) + g1 * bflo(b.x); v[j].y += g0 * bfhi(a.x) + g1 * bfhi(b.x); v[j].z += g0 * bflo(a.y) + g1 * bflo(b.y); v[j].w += g0 * bfhi(a.y) + g1 * bfhi(b.y);
            s += (v[j].x * v[j].x + v[j].y * v[j].y) + (v[j].z * v[j].z + v[j].w * v[j].w); }
        const float r = 1.0f / sqrtf(wave_sum(s) * (1.f / D) + EPS);
        f32x4* o = (f32x4*)(out + (size_t)t * D) + F.lane;
#pragma unroll
        for (int j = 0; j < 4; ++j) o[64 * j] = v[j] * r * ((const f32x4*)g)[64 * j + F.lane];
    }
}
__device__ __forceinline__ u32x4 ld16(const bf16* p) { return *(const u32x4*)p; }
__device__ __forceinline__ u32x2 ld8(const bf16* p) { return *(const u32x2*)p; }

__device__ __forceinline__ void mixer_a(Frame& F, int l, int b) {
    const bf16* P = WSP(bf16, WS_PROJ); bf16* Y = WSP(bf16, WS_YCAT); const float* cw = F.in[4] + (size_t)l * 3 * 512;
    const int c0 = 8 * F.lane, tb = 64 * b + 8 * F.wave;
    float w0[8], w1[8], w2[8];
#pragma unroll
    for (int j = 0; j < 8; ++j) { w0[j] = cw[c0 + j]; w1[j] = cw[512 + c0 + j]; w2[j] = cw[1024 + c0 + j]; }
    float pm2[8], pm1[8];
#pragma unroll
    for (int r = -2; r < 8; ++r) {
        const int t = tb + r; float pr[8];
        if (t >= 0) { float ah[8], ac[8]; unpack8(ld16(P + (size_t)t * PW + c0), ah); unpack8(ld16(P + (size_t)t * PW + 1024 + c0), ac);
#pragma unroll
            for (int j = 0; j < 8; ++j) pr[j] = ah[j] * ac[j]; }
        else {
#pragma unroll
            for (int j = 0; j < 8; ++j) pr[j] = 0.f; }
        if (r >= 0) { float ab[8], o[8]; unpack8(ld16(P + (size_t)t * PW + 512 + c0), ab);
#pragma unroll
            for (int j = 0; j < 8; ++j) o[j] = ab[j] * (w0[j] * pm2[j] + w1[j] * pm1[j] + w2[j] * pr[j]);
            *(u32x4*)(Y + (size_t)t * YW + c0) = pack8(o); }
#pragma unroll
        for (int j = 0; j < 8; ++j) { pm2[j] = pm1[j]; pm1[j] = pr[j]; }
    }
}

__device__ __forceinline__ void mixer_d(Frame& F, int l, int b) {
    const bf16* P = WSP(bf16, WS_PROJ); bf16* Y = WSP(bf16, WS_YCAT);
    LAS unsigned char* RAW = F.lds;
    LAS unsigned char* PL = F.lds + 21504;
    const int t0 = 64 * b, fr = F.lane & 15, fq = F.lane >> 4;
    for (int g = 0; g < 4; ++g) {
        const int win = 2 << g;
        for (int i = F.tid; i < 79 * 16; i += NTHR) { const int r = i >> 4, c8 = i & 15, t = t0 - 15 + r;
            u32x4 v = (u32x4){0u, 0u, 0u, 0u}; if (t >= 0) v = ld16(P + (size_t)t * PW + 5632 + g * 128 + 8 * c8);
            *(LAS u32x4*)(RAW + r * 272 + c8 * 16) = v; }
        __syncthreads();
        for (int i = F.tid; i < 64 * 16; i += NTHR) { const int r = i >> 4, c8 = i & 15, t = t0 + r;
            float s[8], x0[8];
#pragma unroll
            for (int j = 0; j < 8; ++j) s[j] = 0.f;
            for (int k = 0; k < win; ++k) { float x[8]; unpack8(*(const LAS u32x4*)(RAW + (r + 15 - k) * 272 + c8 * 16), x);
#pragma unroll
                for (int j = 0; j < 8; ++j) s[j] += x[j];
                if (k == 0) {
#pragma unroll
                    for (int j = 0; j < 8; ++j) x0[j] = x[j]; } }
            const float inv = 1.0f / (float)((t + 1 < win) ? t + 1 : win);
#pragma unroll
            for (int j = 0; j < 8; ++j) s[j] = s[j] * inv - x0[j];
            *(LAS u32x4*)(PL + r * 272 + c8 * 16) = pack8(s); }
        __syncthreads();
        const bf16* Q = WSP(bf16, WS_SMALL + SM_POOLT) + ((size_t)l * 4 + g) * 128 * 128 + (size_t)(16 * F.wave + fr) * 128 + 8 * fq;
        f32x4 acc[4];
#pragma unroll
        for (int m = 0; m < 4; ++m) acc[m] = (f32x4){0.f, 0.f, 0.f, 0.f};
#pragma unroll
        for (int kk = 0; kk < 4; ++kk) { const bf16x8 q = gfrag(Q + 32 * kk);
#pragma unroll
            for (int m = 0; m < 4; ++m) { const bf16x8 p = ldsfrag(PL, (16 * m + fr) * 272 + (32 * kk + 8 * fq) * 2); MMA16(acc[m], q, p); } }
        const int d0 = 16 * F.wave + 4 * fq; const f32x4 sc = *(const f32x4*)(F.in[16] + (size_t)l * 512 + g * 128 + d0);
#pragma unroll
        for (int m = 0; m < 4; ++m) { const f32x4 v = acc[m] * sc; u32x2 w; w.x = cvt_pk_bf16(v[0], v[1]); w.y = cvt_pk_bf16(v[2], v[3]);
            *(u32x2*)(Y + (size_t)(t0 + 16 * m + fr) * YW + 2048 + g * 128 + d0) = w; }
        __syncthreads();
    }
}

__device__ __forceinline__ void mixer_c(Frame& F, int l, int blk, int gp) {
    const bf16* P = WSP(bf16, WS_PROJ); bf16* Y = WSP(bf16, WS_YCAT);
    LAS float* MU = (LAS float*)F.lds; LAS float* RS = (LAS float*)(F.lds + 512); LAS unsigned char* VR = F.lds + 1024;
    const int t0 = 128 * blk, fr = F.lane & 15, fq = F.lane >> 4;
    for (int i = 0; i < 16; ++i) { const int row = 16 * F.wave + i; float x[8]; unpack8(ld16(P + (size_t)(t0 + row) * PW + 5120 + 8 * F.lane), x);
        float s = 0.f, q = 0.f;
#pragma unroll
        for (int j = 0; j < 8; ++j) { s += x[j]; q += x[j] * x[j]; }
        s = wave_sum(s); q = wave_sum(q);
        if (F.lane == 0) { const float mu = s * (1.f / 512.f); const float var = fmaxf(q * (1.f / 512.f) - mu * mu, 0.f); MU[row] = mu; RS[row] = 1.0f / sqrtf(var + EPS); } }
    __syncthreads();
    { const int ch8 = F.lane & 31, par = F.lane >> 5, cv = gp * 256 + 8 * ch8;
      float lg[8], lb[8];
#pragma unroll
      for (int j = 0; j < 8; ++j) { lg[j] = F.in[11][(size_t)l * 512 + cv + j]; lb[j] = F.in[12][(size_t)l * 512 + cv + j]; }
      for (int i = 0; i < 8; ++i) { const int row = 16 * F.wave + 2 * i + par; float x[8]; unpack8(ld16(P + (size_t)(t0 + row) * PW + 5120 + cv), x);
          const float mu = MU[row], rs = RS[row];
#pragma unroll
          for (int j = 0; j < 8; ++j) x[j] = (x[j] - mu) * rs * lg[j] + lb[j];
          *(LAS u32x4*)(VR + row * 528 + 16 * ch8) = pack8(x); } }
    __syncthreads();
    const int g = 2 * gp + (F.wave >> 2);
    const bf16* Wm = WSP(bf16, WS_SMALL + SM_GMW) + ((size_t)l * 4 + g) * 128 * 128;
    f32x4 acc[8][2];
#pragma unroll
    for (int m = 0; m < 8; ++m) { acc[m][0] = (f32x4){0.f, 0.f, 0.f, 0.f}; acc[m][1] = (f32x4){0.f, 0.f, 0.f, 0.f}; }
#pragma unroll
    for (int m = 0; m < 8; ++m) {
#pragma unroll
        for (int kk = 0; kk < 4; ++kk) if (kk <= (m >> 1)) { const bf16x8 p = gfrag(Wm + (size_t)(16 * m + fr) * 128 + 32 * kk + 8 * fq);
#pragma unroll
            for (int x = 0; x < 2; ++x) { const bf16x8 q = ldsfrag_tr(VR, 528, 32 * kk, 16 * (2 * F.wave + x), fr, fq); MMA16(acc[m][x], q, p); } } }
#pragma unroll
    for (int m = 0; m < 8; ++m) { const int tl = 16 * m + fr; const float bias = F.in[14][((size_t)l * 4 + g) * 128 + tl];
#pragma unroll
        for (int x = 0; x < 2; ++x) { const int cl = 16 * ((2 * F.wave + x) & 7) + 4 * fq; const u32x2 u = ld8(P + (size_t)(t0 + tl) * PW + 4608 + g * 128 + cl);
            const f32x4 a = acc[m][x]; u32x2 w; w.x = cvt_pk_bf16(bflo(u.x) * (a[0] + bias), bfhi(u.x) * (a[1] + bias)); w.y = cvt_pk_bf16(bflo(u.y) * (a[2] + bias), bfhi(u.y) * (a[3] + bias));
            *(u32x2*)(Y + (size_t)(t0 + tl) * YW + 1536 + g * 128 + cl) = w; } }
    __syncthreads();
}

constexpr int S1_DTV = 0, S1_DAC = 4096, S1_WV = 8192, S1_RED = 12288, S1_CL = 12288, S1_BL = 29696, S1_XR = 47104, S1_SH = 80896, XRP = 528;
template <int MODE = 0> __device__ __forceinline__ void ssd1_chunk(Frame& F, int l, int c) {
    const bf16* P = WSP(bf16, WS_PROJ); bf16* Y = WSP(bf16, WS_YCAT); const bf16* H = WSP(bf16, WS_H);
    LAS unsigned char* lds = F.lds; LAS float* DTV = (LAS float*)(lds + S1_DTV); LAS float* DAC = (LAS float*)(lds + S1_DAC); LAS float* WV = (LAS float*)(lds + S1_WV); LAS float* RED = (LAS float*)(lds + S1_RED);
    const int t0 = 64 * c, fr = F.lane & 15, fq = F.lane >> 4, wave = F.wave, lane = F.lane;
    { f32x4 acc[4];
#pragma unroll
      for (int m = 0; m < 4; ++m) acc[m] = (f32x4){0.f, 0.f, 0.f, 0.f};
      const bf16* Hp = H + (size_t)(t0 + fr) * D + wave * 128 + 8 * fq; const bf16* Wd = WSP(bf16, WS_SMALL + SM_WDT) + (size_t)l * 16384 + fr * 1024 + wave * 128 + 8 * fq;
#pragma unroll
      for (int kk = 0; kk < 4; ++kk) { const bf16x8 q = gfrag(Wd + 32 * kk);
#pragma unroll
          for (int m = 0; m < 4; ++m) { const bf16x8 p = gfrag(Hp + (size_t)(16 * m) * D + 32 * kk); MMA16(acc[m], q, p); } }
#pragma unroll
      for (int m = 0; m < 4; ++m) *(LAS f32x4*)(RED + (wave * 64 + 16 * m + fr) * 16 + 4 * fq) = acc[m]; }
    __syncthreads();
    for (int o = F.tid; o < 1024; o += NTHR) { float s = 0.f;
#pragma unroll
        for (int w = 0; w < 8; ++w) s += RED[w * 1024 + o];
        const int j = o & 15, tt = o >> 4; const float dt = softplus_f(s + F.in[7][l * 16 + j]); DTV[j * 64 + tt] = dt; DAC[j * 64 + tt] = -expf(F.in[8][l * 16 + j]) * dt; }
    __syncthreads();
    if (F.tid < 16) { float run = 0.f; for (int t = 0; t < 64; ++t) { run += DAC[F.tid * 64 + t]; DAC[F.tid * 64 + t] = run; } }
    __syncthreads();
    for (int o = F.tid; o < 1024; o += NTHR) { const int j = o & 15, tt = o >> 4, q = j * 64 + tt; WV[q] = DTV[q] * expf(DAC[j * 64 + 63] - DAC[q]); WSP(float, WS_DACS)[(size_t)t0 * 16 + o] = DAC[q]; }
    __syncthreads();
    if (MODE == 1) return;
    for (int g = 0; g < 4; ++g) {
        { const int chx = lane < 32 ? g * 256 + 8 * lane : (lane < 48 ? 1024 + g * 128 + 8 * (lane - 32) : 1536 + g * 128 + 8 * (lane - 48));
          const float* cw = F.in[5] + (size_t)l * 4 * 2048 + chx; const float* cb = F.in[6] + (size_t)l * 2048 + chx;
          float w0[8], w1[8], w2[8], w3[8], bi[8];
#pragma unroll
          for (int j = 0; j < 8; ++j) { w0[j] = cw[j]; w1[j] = cw[2048 + j]; w2[j] = cw[4096 + j]; w3[j] = cw[6144 + j]; bi[j] = cb[j]; }
          u32x4 raw[11];
#pragma unroll
          for (int r = 0; r < 11; ++r) { const int t = t0 + 8 * wave + r - 3; raw[r] = (u32x4){0u, 0u, 0u, 0u}; if (t >= 0) raw[r] = ld16(P + (size_t)t * PW + 2560 + chx); }
          float x3[8], x2[8], x1[8]; unpack8(raw[0], x3); unpack8(raw[1], x2); unpack8(raw[2], x1);
#pragma unroll
          for (int r = 0; r < 8; ++r) { float x0[8], o[8]; unpack8(raw[3 + r], x0); const int row = 8 * wave + r;
#pragma unroll
              for (int j = 0; j < 8; ++j) { o[j] = silu_f(bi[j] + w0[j] * x3[j] + w1[j] * x2[j] + w2[j] * x1[j] + w3[j] * x0[j]); x3[j] = x2[j]; x2[j] = x1[j]; x1[j] = x0[j]; }
              const u32x4 pk = pack8(o);
              if (lane >= 48) { const int n0 = 8 * (lane - 48); *(LAS u32x4*)(lds + S1_CL + row * 272 + n0 * 2) = pk; *(u32x4*)(WSP(bf16, WS_CC) + (size_t)(t0 + row) * 512 + g * 128 + n0) = pk; }
              else if (lane >= 32) { *(LAS u32x4*)(lds + S1_BL + row * 272 + 16 * (lane - 32)) = pk; }
              else { *(LAS u32x4*)(lds + S1_XR + row * XRP + 16 * lane) = pk; } } }
        __syncthreads();
        if (MODE == 2) { __syncthreads(); continue; }
        { const int mi = wave >> 1, nb = (wave & 1) * 2;
          f32x4 cbv[2] = {(f32x4){0.f, 0.f, 0.f, 0.f}, (f32x4){0.f, 0.f, 0.f, 0.f}};
#pragma unroll
          for (int kk = 0; kk < 4; ++kk) { const bf16x8 p = ldsfrag(lds, S1_CL + (16 * mi + fr) * 272 + (32 * kk + 8 * fq) * 2);
#pragma unroll
              for (int x = 0; x < 2; ++x) if (nb + x <= mi) { const bf16x8 q = ldsfrag(lds, S1_BL + (16 * (nb + x) + fr) * 272 + (32 * kk + 8 * fq) * 2); MMA16(cbv[x], q, p); } }
          const int lrow = 16 * mi + fr;
#pragma unroll
          for (int hl = 0; hl < 4; ++hl) { const int hh = 4 * g + hl; const float dl = DAC[hh * 64 + lrow];
#pragma unroll
              for (int x = 0; x < 2; ++x) { const int s0 = 16 * (nb + x) + 4 * fq; float v[4];
#pragma unroll
                  for (int r = 0; r < 4; ++r) { const int s = s0 + r; const bool ok = (nb + x <= mi) && (s <= lrow); const float e = ok ? fast_exp(fminf(dl - DAC[hh * 64 + s], 0.f)) * DTV[hh * 64 + s] : 0.f; v[r] = ok ? cbv[x][r] * e : 0.f; }
                  u32x2 w; w.x = cvt_pk_bf16(v[0], v[1]); w.y = cvt_pk_bf16(v[2], v[3]);
                  *(LAS u32x2*)(lds + S1_SH + ((hl * 64 + lrow) * 72 + s0) * 2) = w; } } }
        __syncthreads();
        { const int hl = wave >> 1, hh = 4 * g + hl;
          const float dsk = F.in[9][l * 16 + hh];
#pragma unroll
          for (int m2 = 0; m2 < 2; ++m2) { const int mi = 2 * (wave & 1) + m2, nk = (mi >> 1) + 1;
              f32x4 y[4];
#pragma unroll
              for (int pi = 0; pi < 4; ++pi) y[pi] = (f32x4){0.f, 0.f, 0.f, 0.f};
#pragma unroll
              for (int kk = 0; kk < 2; ++kk) if (kk < nk) { const bf16x8 p = ldsfrag(lds, S1_SH + ((hl * 64 + 16 * mi + fr) * 72 + 32 * kk + 8 * fq) * 2);
#pragma unroll
                  for (int pi = 0; pi < 4; ++pi) { const bf16x8 q = ldsfrag_tr(lds + S1_XR, XRP, 32 * kk, hl * 64 + 16 * pi, fr, fq); MMA16(y[pi], q, p); } }
              const int lrow = 16 * mi + fr;
#pragma unroll
              for (int pi = 0; pi < 4; ++pi) { const int p0 = 16 * pi + 4 * fq; float xs[4];
                  { const u32x2 xr = *(const LAS u32x2*)(lds + S1_XR + lrow * XRP + (hl * 64 + p0) * 2); xs[0] = bflo(xr.x); xs[1] = bfhi(xr.x); xs[2] = bflo(xr.y); xs[3] = bfhi(xr.y); }
                  u32x2 w; w.x = cvt_pk_bf16(y[pi][0] + dsk * xs[0], y[pi][1] + dsk * xs[1]); w.y = cvt_pk_bf16(y[pi][2] + dsk * xs[2], y[pi][3] + dsk * xs[3]);
                  *(u32x2*)(Y + (size_t)(t0 + lrow) * YW + 512 + hh * 64 + p0) = w; } }
          f32x4 st[4][4];
#pragma unroll
          for (int pi = 0; pi < 4; ++pi)
#pragma unroll
              for (int nx = 0; nx < 4; ++nx) st[pi][nx] = (f32x4){0.f, 0.f, 0.f, 0.f};
#pragma unroll
          for (int kk = 0; kk < 2; ++kk) { float wv[8];
              { const f32x4 wa = *(const LAS f32x4*)(WV + hh * 64 + 32 * kk + 8 * fq), wb = *(const LAS f32x4*)(WV + hh * 64 + 32 * kk + 8 * fq + 4); wv[0] = wa[0]; wv[1] = wa[1]; wv[2] = wa[2]; wv[3] = wa[3]; wv[4] = wb[0]; wv[5] = wb[1]; wv[6] = wb[2]; wv[7] = wb[3]; }
              bf16x8 pa[4];
#pragma unroll
              for (int pi = 0; pi < 4; ++pi) { float xv[8]; unpack8(__builtin_bit_cast(u32x4, ldsfrag_tr(lds + S1_XR, XRP, 32 * kk, hl * 64 + 16 * pi, fr, fq)), xv);
#pragma unroll
                  for (int j = 0; j < 8; ++j) xv[j] *= wv[j];
                  const u32x4 pk = pack8(xv); pa[pi] = __builtin_bit_cast(bf16x8, pk); }
#pragma unroll
              for (int nx = 0; nx < 4; ++nx) { const bf16x8 q = ldsfrag_tr(lds + S1_BL, 272, 32 * kk, 16 * (4 * (wave & 1) + nx), fr, fq);
#pragma unroll
                  for (int pi = 0; pi < 4; ++pi) MMA16(st[pi][nx], q, pa[pi]); } }
          bf16* ST = WSP(bf16, WS_STATES) + ((size_t)c * 16 + hh) * 8192;
#pragma unroll
          for (int pi = 0; pi < 4; ++pi)
#pragma unroll
              for (int nx = 0; nx < 4; ++nx) { const f32x4 v = st[pi][nx]; u32x2 w; w.x = cvt_pk_bf16(v[0], v[1]); w.y = cvt_pk_bf16(v[2], v[3]);
                  *(u32x2*)(ST + (size_t)(16 * pi + fr) * 128 + 16 * (4 * (wave & 1) + nx) + 4 * fq) = w; } }
        __syncthreads();
    }
}

template <bool DUMMY = false> __device__ __forceinline__ void scan_phase(Frame& F) {
    const int e = F.bid * NTHR + F.tid, hh = e >> 13;
    bf16* ST = WSP(bf16, WS_STATES) + e; const float* DA = WSP(float, WS_DACS) + 63 * 16 + hh;
    float run = 0.f;
    for (int cb = 0; cb < 256; cb += 16) { bf16 s[16]; float d[16];
#pragma unroll
        for (int i = 0; i < 16; ++i) { s[i] = ST[(size_t)(cb + i) * 131072]; d[i] = DA[(size_t)(cb + i) * 64 * 16]; }
#pragma unroll
        for (int i = 0; i < 16; ++i) { if (!DUMMY) ST[(size_t)(cb + i) * 131072] = f2bf(run); run = run * expf(d[i]) + bf1(s[i]); } }
    if (DUMMY) WSP(float, WS_R + 386 * MiB)[e] = run;
}

template <bool DUMMY = false> __device__ __forceinline__ void ssd3_chunk(Frame& F, int l, int c) {
    const bf16* P = WSP(bf16, WS_PROJ); bf16* Y = WSP(bf16, WS_YCAT); bf16* YO = DUMMY ? WSP(bf16, WS_PROJ) : Y; const int yo_pitch = DUMMY ? PW : YW, yo_col = DUMMY ? 0 : 512; const bf16* CCp = WSP(bf16, WS_CC); const float* DACS = WSP(float, WS_DACS);
    LAS float* SQ = (LAS float*)F.lds;
    const int t0 = 64 * c, fr = F.lane & 15, fq = F.lane >> 4, wave = F.wave;
    for (int g = 0; g < 4; ++g) {
        const int hl = wave >> 1, hh = 4 * g + hl, pb = 2 * (wave & 1);
        const bf16* HI = WSP(bf16, WS_STATES) + ((size_t)c * 16 + hh) * 8192;
        bf16x8 hq[2][4];
#pragma unroll
        for (int px = 0; px < 2; ++px)
#pragma unroll
            for (int kk = 0; kk < 4; ++kk) hq[px][kk] = gfrag(HI + (size_t)(16 * (pb + px) + fr) * 128 + 32 * kk + 8 * fq);
        f32x4 y[4][2];
#pragma unroll
        for (int mi = 0; mi < 4; ++mi) { y[mi][0] = (f32x4){0.f, 0.f, 0.f, 0.f}; y[mi][1] = (f32x4){0.f, 0.f, 0.f, 0.f};
#pragma unroll
            for (int kk = 0; kk < 4; ++kk) { const bf16x8 p = gfrag(CCp + (size_t)(t0 + 16 * mi + fr) * 512 + g * 128 + 32 * kk + 8 * fq);
#pragma unroll
                for (int px = 0; px < 2; ++px) MMA16(y[mi][px], hq[px][kk], p); } }
#pragma unroll
        for (int mi = 0; mi < 4; ++mi) { const int t = t0 + 16 * mi + fr; const float e = expf(DACS[(size_t)t * 16 + hh]); float sq = 0.f;
#pragma unroll
            for (int px = 0; px < 2; ++px) { const int ch = hh * 64 + 16 * (pb + px) + 4 * fq; const u32x2 yd = ld8(Y + (size_t)t * YW + 512 + ch), z = ld8(P + (size_t)t * PW + 1536 + ch);
                f32x4 v; v[0] = (bflo(yd.x) + e * y[mi][px][0]) * silu_f(bflo(z.x)); v[1] = (bfhi(yd.x) + e * y[mi][px][1]) * silu_f(bfhi(z.x));
                v[2] = (bflo(yd.y) + e * y[mi][px][2]) * silu_f(bflo(z.y)); v[3] = (bfhi(yd.y) + e * y[mi][px][3]) * silu_f(bfhi(z.y));
                y[mi][px] = v; sq += (v[0] * v[0] + v[1] * v[1]) + (v[2] * v[2] + v[3] * v[3]); }
            sq += __shfl_xor(sq, 16); sq += __shfl_xor(sq, 32);
            if (fq == 0) SQ[wave * 64 + 16 * mi + fr] = sq; }
        __syncthreads();
#pragma unroll
        for (int mi = 0; mi < 4; ++mi) { const int lr = 16 * mi + fr, t = t0 + lr; float tot = 0.f;
#pragma unroll
            for (int w = 0; w < 8; ++w) tot += SQ[w * 64 + lr];
            const float rstd = 1.0f / sqrtf(tot * (1.f / 256.f) + EPS);
#pragma unroll
            for (int px = 0; px < 2; ++px) { const int ch = hh * 64 + 16 * (pb + px) + 4 * fq; const f32x4 ng = *(const f32x4*)(F.in[10] + (size_t)l * 1024 + ch); const f32x4 v = y[mi][px] * rstd * ng;
                u32x2 w; w.x = cvt_pk_bf16(v[0], v[1]); w.y = cvt_pk_bf16(v[2], v[3]); *(u32x2*)(YO + (size_t)t * yo_pitch + yo_col + ch) = w; } }
        __syncthreads();
    }
}
struct Args { const float* in[31]; float* out; unsigned char* ws; int ph_lo, ph_hi; };
constexpr int PH_PER_LAYER = 12, N_PHASES = 2 + 2 * PH_PER_LAYER;

#ifndef PMASK
#define PMASK 0x3fff
#endif
#define IN(k) (lo <= (k) && (k) < hi)
#define EN(b) ((PMASK >> (b)) & 1)
#ifndef REPMASK
#define REPMASK 0
#endif
#define NREP(b) (((REPMASK >> (b)) & 1) ? 2 : 1)
#define PHASE_BEGIN() do { int _t = threadIdx.x; asm volatile("" : "+v"(_t)); F.tid = _t; F.lane = _t & 63; } while (0)
#ifdef REPBAR
#define REPEAT(b, ...) do { _Pragma("unroll") for (int _r = 0; _r < NREP(b); ++_r) { if (_r) { xcd_barrier(bar); PHASE_BEGIN(); } __VA_ARGS__; } } while (0)
#else
#define REPEAT(b, ...) do { _Pragma("unroll") for (int _r = 0; _r < NREP(b); ++_r) { __VA_ARGS__; } } while (0)
#endif
#define REPEAT1(b, ...) do { _Pragma("unroll") for (int _r = 0; _r < NREP(b); ++_r) { PHASE_BEGIN(); __VA_ARGS__; } } while (0)
#define SEAM(k) do { if (IN((k) + 1) && MK_N_LAUNCHES == 1) xcd_barrier(bar); } while (0)
template <int l> __device__ __forceinline__ void layer_phases(Frame& F, const XcdBarrier& bar, const int lo, const int hi) {
    const int gw = F.bid * NWAVES + F.wave, NGW = F.G * NWAVES;
    LAS unsigned char* ring = F.lds;
        const int pb = 1 + PH_PER_LAYER * l;
        const float* xin = (l == 0) ? F.in[0] : WSP(float, WS_XC);
        const bf16* W1T = WSP(bf16, WS_W1T) + (size_t)l * 10240 * D;
        if (EN(1) && IN(pb + 0) && l == 1) { PHASE_BEGIN(); rmsnorm_phase(F, xin, F.in[1] + D, WSP(bf16, WS_H)); SEAM(pb + 0); }
        if (EN(2) && IN(pb + 1)) { PHASE_BEGIN();
            pg8::DenseSched S; S.init(WSP(bf16, WS_H), W1T, L, PW, D, F.G, F.bid);
            pg8::EpiBf16Act E{WSP(bf16, WS_PROJ), PW, 18, 22, 0};
            REPEAT(2, pg8::gemm_phase<pg8::EpiBf16Act, pg8::DenseSched, true, false>(ring, D, S, E));
            SEAM(pb + 1);
        }
        if (EN(3) && IN(pb + 2)) { PHASE_BEGIN();
#ifndef MIXMASK
#define MIXMASK 15
#endif
            #ifndef SSD1MODE
#define SSD1MODE 0
#endif
#ifndef MIXREP
#define MIXREP 15
#endif
            REPEAT1(3, const int mm = (_r == 0) ? 15 : MIXREP; if (mm & 1) { if (_r == 0) ssd1_chunk<0>(F, l, F.bid); else ssd1_chunk<SSD1MODE>(F, l, F.bid); } if (mm & 2) mixer_c(F, l, F.bid >> 1, F.bid & 1); if (mm & 4) mixer_d(F, l, F.bid); if (mm & 8) mixer_a(F, l, F.bid); __syncthreads());
            SEAM(pb + 2);
        }
        if (EN(4) && IN(pb + 3)) { PHASE_BEGIN(); if (NREP(4) == 2) { scan_phase<true>(F); PHASE_BEGIN(); } scan_phase<false>(F); SEAM(pb + 3); }
        if (EN(5) && IN(pb + 4)) { PHASE_BEGIN(); if (NREP(5) == 2) { ssd3_chunk<true>(F, l, F.bid); PHASE_BEGIN(); } ssd3_chunk<false>(F, l, F.bid); SEAM(pb + 4); }
        if (EN(6) && IN(pb + 5)) { PHASE_BEGIN();
            pg8::DenseSched S; S.init(WSP(bf16, WS_H), W1T + (size_t)PW * D, L, GW, D, F.G, F.bid);
            pg8::EpiBf16Act E{WSP(bf16, WS_GATES), GW, 0, 0, 1};
            REPEAT(6, pg8::gemm_phase<pg8::EpiBf16Act, pg8::DenseSched, true, false>(ring, D, S, E));
            SEAM(pb + 5);
        }
        if (EN(7) && IN(pb + 6)) { PHASE_BEGIN();
            pg8::DenseSched S; S.init(WSP(bf16, WS_YCAT), WSP(bf16, WS_BRT) + (size_t)l * D * YW, L, D, YW, F.G, F.bid);
            pg8::EpiMerge E{WSP(bf16, WS_GATES), WSP(bf16, WS_MERGED)};
            REPEAT(7, pg8::gemm_phase<pg8::EpiMerge, pg8::DenseSched, false, false>(ring, YW, S, E));
            SEAM(pb + 6);
        }
        if (EN(8) && IN(pb + 7)) { PHASE_BEGIN();
            pg8::DenseSched S; S.init(WSP(bf16, WS_MERGED), WSP(bf16, WS_OUTT) + (size_t)l * D * D, L, D, D, F.G, F.bid);
            pg8::EpiResid E{xin, WSP(float, WS_XC), D};
            pg8::gemm_phase<pg8::EpiResid, pg8::DenseSched, false, false>(ring, D, S, E);
            SEAM(pb + 7);
        }
        if (EN(9) && IN(pb + 8)) { PHASE_BEGIN();
            REPEAT(9, if (l == 0) rmsnorm_phase(F, WSP(float, WS_XC), F.in[22], WSP(bf16, WS_H2)); else { route_phase(F, WSP(float, WS_XC), F.in[22] + D, WSP(unsigned char, WS_H2), F.in[26]); __syncthreads(); convert_moe_weights(F, gw, NGW); __syncthreads(); });
            SEAM(pb + 8);
        }
        if (EN(10) && IN(pb + 9) && l == 1) { PHASE_BEGIN(); assign_phase(F); SEAM(pb + 9); }
        if (EN(11) && IN(pb + 10)) { PHASE_BEGIN();
            if (l == 0) {
                pg8::DenseSched S; S.init(WSP(bf16, WS_H2), WSP(bf16, WS_UPT), L, 2 * DFF, D, F.G, F.bid);
                pg8::EpiSwiglu E{WSP(bf16, WS_ACT), DFF};
                REPEAT(11, pg8::gemm_phase<pg8::EpiSwiglu, pg8::DenseSched, true, false>(ring, D, S, E));
            } else {
                MoeUpSched S; S.o.init(__builtin_amdgcn_readfirstlane(WSP(int, WS_ROUTE + RT_NT)[0]), 2 * DFE / 256, F.G, F.bid); S.A = (const char*)WSP(bf16, WS_H2); S.Bt = (const char*)WSP(bf16, WS_MOEUP);
                S.tile_e = WSP(int, WS_ROUTE + RT_TILEE); S.rowidx = WSP(int, WS_ROUTE + RT_ROWIDX);
                pg8::EpiSwigluF8 E{WSP(unsigned char, WS_ACTM), DFE, 1.f / MOE_UP_WSCALE};
                REPEAT(11, pg8::gemm_phase<pg8::EpiSwigluF8, MoeUpSched, true, true, 1>(ring, D, S, E));
            }
            SEAM(pb + 10);
        }
        if (EN(12) && IN(pb + 11)) { PHASE_BEGIN();
            if (l == 0) {
                pg8::DenseSched S; S.init(WSP(bf16, WS_ACT), WSP(bf16, WS_DNT), L, D, DFF, F.G, F.bid);
                pg8::EpiResid E{WSP(float, WS_XC), WSP(float, WS_XC), D};
                pg8::gemm_phase<pg8::EpiResid, pg8::DenseSched, false, false>(ring, DFF, S, E);
            } else {
                MoeDnSched S; S.o.init(__builtin_amdgcn_readfirstlane(WSP(int, WS_ROUTE + RT_NT)[0]), D / 256, F.G, F.bid); S.A = (const char*)WSP(bf16, WS_ACTM); S.Bt = (const char*)WSP(bf16, WS_MOEDN); S.tile_e = WSP(int, WS_ROUTE + RT_TILEE);
                pg8::EpiBf16Scale E{WSP(bf16, WS_YBUF), D, 1.f / MOE_DN_WSCALE};
                REPEAT(12, pg8::gemm_phase<pg8::EpiBf16Scale, MoeDnSched, true, false, 1>(ring, DFE, S, E));
            }
            SEAM(pb + 11);
        }

}
__global__ void __launch_bounds__(NTHR, 2) fwd_kernel(Args args) {
    extern __shared__ __attribute__((aligned(16))) unsigned char lds_raw[];
    Frame F;
    F.lds = (LAS unsigned char*)lds_raw;
    F.MISC = (volatile LAS unsigned*)(F.lds + MISC_OFF);
    F.tid = threadIdx.x; F.lane = F.tid & 63; F.wave = __builtin_amdgcn_readfirstlane(F.tid >> 6);
    F.G = gridDim.x; F.bid = blockIdx.x;
    F.ws = args.ws; F.ctl = (unsigned*)(args.ws + WS_CTL); F.in = args.in; F.out = args.out;
    for (int u = F.tid; u < (LDS_BYTES - MISC_OFF) / 4; u += NTHR) ((LAS unsigned*)(F.lds + MISC_OFF))[u] = 0u;
    __syncthreads();
    XcdBarrier bar; bar.bar = F.ctl + CW_BAR; bar.x = 0; bar.st = nullptr;
    if (MK_N_LAUNCHES == 1) bar = xcd_barrier_post(F.ctl + CW_BAR, F.MISC + 8);
    const int lo = args.ph_lo, hi = args.ph_hi;
    const int gw = F.bid * NWAVES + F.wave, NGW = F.G * NWAVES;
    LAS unsigned char* ring = F.lds;

    if (EN(0) && IN(0)) { PHASE_BEGIN();
        REPEAT(0, convert_layer_weights(F, 0, gw, NGW); convert_layer_weights(F, 1, gw, NGW); convert_ffn_weights(F, gw, NGW); rmsnorm_phase(F, F.in[0], F.in[1], WSP(bf16, WS_H)); __syncthreads());
        SEAM(0);
#ifdef EXTRA_BARS
        for (int i = 0; i < EXTRA_BARS; ++i) xcd_barrier(bar);
#endif
    }
#ifndef LMASK
#define LMASK 3
#endif
    if (LMASK & 1) layer_phases<0>(F, bar, lo, hi);
    if (LMASK & 2) layer_phases<1>(F, bar, lo, hi);
    if (EN(13) && IN(N_PHASES - 1)) final_phase(F, WSP(float, WS_XC), WSP(bf16, WS_YBUF), F.in[30], F.out);
#undef IN
#undef SEAM
}

extern "C" void kernel_launch(void* const* d_in, const int* in_sizes, int n_in, void* d_out, int out_size, void* d_ws, size_t ws_size, hipStream_t stream) {
    static int grid = 0;
    if (grid == 0) {
        if (n_in != 31 || in_sizes[0] != L * D || out_size != L * D || ws_size < WS_END) { fprintf(stderr, "kernel_launch: unexpected problem (n_in %d, out %d, ws %zu); nothing launched\n", n_in, out_size, ws_size); grid = -1; return; }
        int dev = 0, cus = 0, per_cu = 0;
        if (hipGetDevice(&dev) != hipSuccess || hipDeviceGetAttribute(&cus, hipDeviceAttributeMultiprocessorCount, dev) != hipSuccess) { grid = -1; return; }
        if (hipFuncSetAttribute((const void*)fwd_kernel, hipFuncAttributeMaxDynamicSharedMemorySize, LDS_BYTES) != hipSuccess) { fprintf(stderr, "kernel_launch: hipFuncSetAttribute failed\n"); grid = -1; return; }
        if (hipOccupancyMaxActiveBlocksPerMultiprocessor(&per_cu, (const void*)fwd_kernel, NTHR, LDS_BYTES) != hipSuccess || per_cu < 1) { fprintf(stderr, "kernel_launch: occupancy query reports %d workgroups per CU\n", per_cu); (void)hipGetLastError(); grid = -1; return; }
        if (cus != 256) { fprintf(stderr, "kernel_launch: built for 256 CUs, found %d\n", cus); grid = -1; return; }
        grid = 256;
    }
    if (grid < 0) return;
    if (hipMemsetAsync((char*)d_ws + WS_CTL, 0, CTL_ZERO_BYTES, stream) != hipSuccess) return;
    Args a{};
    for (int i = 0; i < 31; ++i) a.in[i] = (const float*)d_in[i];
    a.out = (float*)d_out; a.ws = (unsigned char*)d_ws;
    if (MK_N_LAUNCHES == 1) { a.ph_lo = 0; a.ph_hi = N_PHASES; hipLaunchKernelGGL(fwd_kernel, dim3(grid), dim3(NTHR), LDS_BYTES, stream, a); }
    else for (int p = 0; p < N_PHASES; ++p) {
        if (p == 1 || p == 1 + 9) continue;
        a.ph_lo = p; a.ph_hi = p + 1; hipLaunchKernelGGL(fwd_kernel, dim3(grid), dim3(NTHR), LDS_BYTES, stream, a);
    }
}
```

```cpp
#define MK_N_LAUNCHES 1
#include <hip/hip_runtime.h>
#include <cstdio>
#include <cstdint>

#ifndef MK_N_LAUNCHES
#define MK_N_LAUNCHES 1
#endif

#define LAS __attribute__((address_space(3)))
#define GAS __attribute__((address_space(1)))
typedef unsigned short bf16;
typedef short bf16x8 __attribute__((ext_vector_type(8)));
typedef float f32x4 __attribute__((ext_vector_type(4)));
typedef float f32x2 __attribute__((ext_vector_type(2)));
typedef unsigned u32x4 __attribute__((ext_vector_type(4)));
typedef unsigned u32x2 __attribute__((ext_vector_type(2)));
#define RLX_AGENT __ATOMIC_RELAXED, __HIP_MEMORY_SCOPE_AGENT
#define LDS_WAIT() asm volatile("s_waitcnt lgkmcnt(0)" ::: "memory")
#define VM_WAIT() asm volatile("s_waitcnt vmcnt(0)" ::: "memory")

constexpr int L = 16384, D = 1024, NWAVES = 8, NTHR = 512;
constexpr int PW = 6144;
constexpr int GW = 4096;
constexpr int YW = 2560;
constexpr int DFF = 2816, DFE = 3584, NE = 8;
constexpr int MAXSLOT = 34816;
constexpr float EPS = 1e-6f;

constexpr size_t MiB = 1u << 20;
constexpr size_t WS_CTL = 0, CTL_ZERO_BYTES = 1 * MiB;
constexpr size_t WS_SMALL = 1 * MiB;
constexpr size_t SM_GMW = 0, SM_POOLT = 256 * 1024, SM_WDT = 512 * 1024;
constexpr size_t WS_W1T = 2 * MiB;
constexpr size_t WS_BRT = 42 * MiB;
constexpr size_t WS_OUTT = 52 * MiB;
constexpr size_t WS_UPT = 56 * MiB;
constexpr size_t WS_DNT = 67 * MiB;
constexpr size_t WS_MOEDN = 2 * MiB;
constexpr size_t WS_XC = 74 * MiB;
constexpr size_t WS_R = 138 * MiB;
constexpr size_t WS_H = WS_R;
constexpr size_t WS_PROJ = WS_R + 32 * MiB;
constexpr size_t WS_YCAT = WS_R + 224 * MiB;
constexpr size_t WS_STATES = WS_R + 304 * MiB;
constexpr size_t WS_DACS = WS_R + 368 * MiB;
constexpr size_t WS_CC = WS_R + 369 * MiB;
constexpr size_t WS_GATES = WS_R + 32 * MiB;
constexpr size_t WS_MERGED = WS_R + 160 * MiB;
constexpr size_t WS_H2 = WS_R;
constexpr size_t WS_ACT = WS_R + 32 * MiB;
constexpr size_t WS_MOEUP = WS_R + 32 * MiB;
constexpr size_t WS_ROUTE = WS_R + 144 * MiB;
constexpr size_t RT_TOPK = 0, RT_CNT = 256 * 1024, RT_ROWIDX = 288 * 1024, RT_TOKSLOT = 448 * 1024, RT_TILEE = 640 * 1024, RT_NT = 644 * 1024;
constexpr size_t WS_ACTM = WS_R + 164 * MiB;
constexpr size_t WS_YBUF = WS_R + 32 * MiB;
constexpr size_t WS_END = 540 * MiB;
static_assert(WS_ACTM + (size_t)MAXSLOT * DFE <= WS_END, "ws map");
static_assert(WS_CC + (size_t)L * 512 * 2 <= WS_END, "ws map");
constexpr int CW_TMO = 0, CW_BAR = 4096;

constexpr int LDS_BYTES = 147456;
constexpr int MISC_OFF = LDS_BYTES - 256;
constexpr int WORK_BYTES = MISC_OFF;

typedef __bf16 bf16x2_t __attribute__((ext_vector_type(2)));
__device__ __forceinline__ unsigned cvt_pk_bf16(float lo, float hi) { const f32x2 v = {lo, hi}; const bf16x2_t r = __builtin_convertvector(v, bf16x2_t); return __builtin_bit_cast(unsigned, r); }
__device__ __forceinline__ unsigned cvt4_fp8(float a, float b, float c, float d) { unsigned r = 0; r = __builtin_amdgcn_cvt_pk_fp8_f32(a, b, r, false); r = __builtin_amdgcn_cvt_pk_fp8_f32(c, d, r, true); return r; }
constexpr float MOE_UP_WSCALE = 32.f, MOE_DN_WSCALE = 64.f;
__device__ __forceinline__ float bflo(unsigned u) { return __uint_as_float(u << 16); }
__device__ __forceinline__ float bfhi(unsigned u) { return __uint_as_float(u & 0xffff0000u); }
__device__ __forceinline__ float bf1(bf16 b) { return __uint_as_float(((unsigned)b) << 16); }
__device__ __forceinline__ bf16 f2bf(float f) { return (bf16)(cvt_pk_bf16(f, 0.f) & 0xffffu); }
__device__ __forceinline__ void unpack8(const u32x4 v, float (&o)[8]) { o[0] = bflo(v.x); o[1] = bfhi(v.x); o[2] = bflo(v.y); o[3] = bfhi(v.y); o[4] = bflo(v.z); o[5] = bfhi(v.z); o[6] = bflo(v.w); o[7] = bfhi(v.w); }
__device__ __forceinline__ u32x4 pack8(const float (&o)[8]) { u32x4 v; v.x = cvt_pk_bf16(o[0], o[1]); v.y = cvt_pk_bf16(o[2], o[3]); v.z = cvt_pk_bf16(o[4], o[5]); v.w = cvt_pk_bf16(o[6], o[7]); return v; }
__device__ __forceinline__ float fast_exp(float x) { return __builtin_amdgcn_exp2f(x * 1.4426950408889634f); }
__device__ __forceinline__ float fast_rcp(float x) { return __builtin_amdgcn_rcpf(x); }
__device__ __forceinline__ float sigmoid_f(float x) { return fast_rcp(1.f + fast_exp(-x)); }
__device__ __forceinline__ float silu_f(float x) { return x * sigmoid_f(x); }
__device__ __forceinline__ float gelu_tanh_f(float x) { const float u = 0.7978845608028654f * (x + 0.044715f * x * x * x); return x * sigmoid_f(2.f * u); }
__device__ __forceinline__ float softplus_f(float x) { return fmaxf(x, 0.f) + log1pf(expf(-fabsf(x))); }
__device__ __forceinline__ float wave_sum(float v) {
#pragma unroll
    for (int o = 1; o < 64; o <<= 1) v += __shfl_xor(v, o);
    return v;
}
#define MMA16(acc, q, p) (acc) = __builtin_amdgcn_mfma_f32_16x16x32_bf16((q), (p), (acc), 0, 0, 0)
__device__ __forceinline__ bf16x8 ldsfrag(LAS unsigned char* base, int byteoff) { return *(const LAS bf16x8*)(base + byteoff); }
__device__ __forceinline__ bf16x8 gfrag(const bf16* p) { return *(const bf16x8*)p; }
typedef short s16x4 __attribute__((ext_vector_type(4)));
__device__ __forceinline__ bf16x8 ldsfrag_tr(LAS unsigned char* base, int pitchB, int k0, int n0, int fr, int fq) {
    LAS unsigned char* p = base + (k0 + 8 * fq + (fr >> 2)) * pitchB + (n0 + 4 * (fr & 3)) * 2;
    const s16x4 a = __builtin_amdgcn_ds_read_tr16_b64_v4i16((LAS s16x4*)p), b = __builtin_amdgcn_ds_read_tr16_b64_v4i16((LAS s16x4*)(p + 4 * pitchB));
    return __builtin_shufflevector(a, b, 0, 1, 2, 3, 4, 5, 6, 7);
}

#define XB_TMO      128
#define XB_XCNT(j)  (256  + 64 * (j))
#define XB_XSUB(j)  (1280 + 64 * (j))
#define XB_XGEN(j)  (2304 + 64 * (j))
#define XB_TOP      3328
#define XB_TOPGEN   3392
#define XCD_BAR_WORDS 3456
#define XB_SPIN_CAP (1u << 18)
__device__ __forceinline__ unsigned xb_ld(unsigned* p)              { return __hip_atomic_load(p, __ATOMIC_RELAXED, __HIP_MEMORY_SCOPE_AGENT); }
__device__ __forceinline__ unsigned xb_add(unsigned* p, unsigned v) { return __hip_atomic_fetch_add(p, v, __ATOMIC_RELAXED, __HIP_MEMORY_SCOPE_AGENT); }
__device__ __forceinline__ unsigned xb_xcc_id() { return (unsigned)__builtin_amdgcn_s_getreg((3 << 11) | 20) & 0xFu; }
#define XB_SPIN(cond, bar) do { unsigned _sp = 0; while (cond) { __builtin_amdgcn_s_sleep(1); \
    if ((++_sp & 255u) == 0u) { if (xb_ld(&(bar)[XB_TMO])) break; if (_sp > XB_SPIN_CAP) { atomicAdd(&(bar)[XB_TMO], 1u); break; } } } } while (0)
struct XcdBarrier { unsigned* bar; unsigned x; volatile LAS unsigned* st; };
__device__ __forceinline__ XcdBarrier xcd_barrier_post(unsigned* bar, volatile LAS unsigned* st) {
    XcdBarrier b; b.bar = bar; b.x = xb_xcc_id(); b.st = st;
    if (threadIdx.x == 0) (void)xb_add(&bar[XB_XCNT(b.x)], 1u);
    return b;
}
__device__ __forceinline__ void xcd_barrier_complete(unsigned* bar, unsigned x, unsigned& nloc, unsigned& nx) {
    const unsigned G = gridDim.x * gridDim.y * gridDim.z;
    unsigned sum, cnt, mine, sp = 0u;
    for (;;) {
        sum = 0u; cnt = 0u; mine = 0u;
#pragma unroll
        for (unsigned j = 0; j < 16; ++j) { const unsigned c = xb_ld(&bar[XB_XCNT(j)]); sum += c; cnt += (c > 0u) ? 1u : 0u; mine = (j == x) ? c : mine; }
        if (sum == G) break;
        __builtin_amdgcn_s_sleep(1);
        if ((++sp & 255u) == 0u) { if (xb_ld(&bar[XB_TMO])) break; if (sp > XB_SPIN_CAP) { atomicAdd(&bar[XB_TMO], 1u); break; } }
    }
    nloc = mine > 0u ? mine : 1u; nx = cnt > 0u ? cnt : 1u;
}
__device__ __forceinline__ void xcd_barrier(const XcdBarrier& b) {
    asm volatile("s_waitcnt vmcnt(0)" ::: "memory");
    __syncthreads();
    if (threadIdx.x == 0) {
        unsigned* bar = b.bar;
        __builtin_amdgcn_s_waitcnt(0);
        unsigned nloc = b.st[0], nx = b.st[1];
        if (nloc == 0u) { xcd_barrier_complete(bar, b.x, nloc, nx); b.st[0] = nloc; b.st[1] = nx; }
        const unsigned old = xb_add(&bar[XB_XSUB(b.x)], 1u);
        const unsigned gen = old / nloc;
        if (old + 1u == (gen + 1u) * nloc) {
            __builtin_amdgcn_fence(__ATOMIC_RELEASE, "agent");
            asm volatile("s_waitcnt vmcnt(0)" ::: "memory");
            const unsigned og = xb_add(&bar[XB_TOP], 1u);
            const unsigned tg = og / nx;
            if (og + 1u == (tg + 1u) * nx) xb_add(&bar[XB_TOPGEN], 1u);
            else XB_SPIN(xb_ld(&bar[XB_TOPGEN]) == tg, bar);
            __builtin_amdgcn_fence(__ATOMIC_ACQUIRE, "agent");
            xb_add(&bar[XB_XGEN(b.x)], 1u);
            asm volatile("s_waitcnt vmcnt(0)" ::: "memory");
        } else {
            XB_SPIN(xb_ld(&bar[XB_XGEN(b.x)]) == gen, bar);
            __builtin_amdgcn_fence(__ATOMIC_ACQUIRE, "agent");
            asm volatile("s_waitcnt vmcnt(0)" ::: "memory");
        }
    }
    __syncthreads();
}
namespace pg8 {
constexpr int BM = 256, BK = 64, HALF = 128, HTB = HALF * BK * 2, STAGE_BYTES = 8 * HTB, NXCD = 8, WGM = 8;
__host__ __device__ __forceinline__ int lds_byte(int r, int c) { const int st = (r >> 4) * 2 + (c >> 5), rr = r & 15, cc = c & 31, ob = rr * 64 + cc * 2; return st * 1024 + (ob ^ (((ob >> 9) & 1) << 5)); }
__host__ __device__ __forceinline__ void stage_rc(int b, int& R, int& C) { const int st = b / 1024, sb = b % 1024, swz = sb ^ (((sb >> 9) & 1) << 5); R = (st >> 1) * 16 + swz / 64; C = (st & 1) * 32 + (swz % 64) / 2; }
__host__ __device__ __forceinline__ int perm32(int rho) { const int n = rho >> 4, i = rho & 15; return 8 * (i >> 2) + 4 * n + (i & 3); }

struct Unit { int pm, pn; const char* a; const char* b; };
struct TileOrder {
    int nM, nN, nwg, G, c;
    __device__ __forceinline__ void init(int nM_, int nN_, int G_, int c_) { nM = nM_; nN = nN_; nwg = nM * nN; G = G_; c = c_; }
    __device__ __forceinline__ bool tile(int i, int& pm, int& pn) const {
        const long Lq = (long)i * G + c; if (Lq >= nwg) return false;
        int wgid = (int)Lq; { const int q = nwg / NXCD, r = nwg % NXCD, xcd = wgid % NXCD, off = wgid / NXCD; wgid = (xcd < r ? xcd * (q + 1) : r * (q + 1) + (xcd - r) * q) + off; }
        const int nig = WGM * nN, gid = wgid / nig, fm = gid * WGM, gsz = (nM - fm) < WGM ? (nM - fm) : WGM;
        pm = fm + ((wgid % nig) % gsz); pn = (wgid % nig) / gsz; return true;
    }
};
struct DenseSched {
    TileOrder o; const char* A; const char* Bt; size_t tstep;
    __device__ __forceinline__ void init(const bf16* A_, const bf16* Bt_, int M, int N, int K, int G, int c) { o.init(M / BM, N / BM, G, c); A = (const char*)A_; Bt = (const char*)Bt_; tstep = (size_t)BM * K * 2; }
    __device__ __forceinline__ bool next(int i, Unit& u) const { if (!o.tile(i, u.pm, u.pn)) return false; u.a = A + (size_t)u.pm * tstep; u.b = Bt + (size_t)u.pn * tstep; return true; }
    __device__ __forceinline__ unsigned arow(const Unit&, int) const { return 0u; }
};

__device__ __forceinline__ unsigned cvt_pk(float lo, float hi) { return cvt_pk_bf16(lo, hi); }

struct EpiBf16Act {
    static constexpr bool PERM = true, HAS_MID = false;
    bf16* O; int ldc; int gelu_lo, gelu_hi; int sig;
    __device__ __forceinline__ void operator()(f32x4 (&acc)[2][2][4][2], const Unit& u, int wr, int wc, int fr, int fq) const {
        asm volatile("" : "+v"(fr), "+v"(fq));
        const int row0 = u.pm * BM + wr * 64 + fr, col0 = u.pn * BM + wc * 32 + 8 * fq;
        const int mode = sig ? 2 : ((u.pn >= gelu_lo && u.pn < gelu_hi) ? 1 : 0);
#pragma unroll
        for (int ai = 0; ai < 2; ++ai)
#pragma unroll
            for (int m = 0; m < 4; ++m) { bf16* rowp = O + (size_t)(row0 + ai * HALF + m * 16) * ldc + col0;
#pragma unroll
                for (int bj = 0; bj < 2; ++bj) { f32x4 v0 = acc[ai][bj][m][0], v1 = acc[ai][bj][m][1];
                    if (mode == 1) {
#pragma unroll
                        for (int j = 0; j < 4; ++j) { v0[j] = gelu_tanh_f(v0[j]); v1[j] = gelu_tanh_f(v1[j]); } }
                    else if (mode == 2) {
#pragma unroll
                        for (int j = 0; j < 4; ++j) { v0[j] = sigmoid_f(v0[j]); v1[j] = sigmoid_f(v1[j]); } }
                    u32x4 w; w.x = cvt_pk(v0[0], v0[1]); w.y = cvt_pk(v0[2], v0[3]); w.z = cvt_pk(v1[0], v1[1]); w.w = cvt_pk(v1[2], v1[3]);
                    *(u32x4*)(rowp + bj * HALF) = w; } }
    }
};
struct EpiSwiglu {
    static constexpr bool PERM = true, HAS_MID = false;
    bf16* O; int ldc;
    __device__ __forceinline__ void operator()(f32x4 (&acc)[2][2][4][2], const Unit& u, int wr, int wc, int fr, int fq) const {
        asm volatile("" : "+v"(fr), "+v"(fq));
        const int row0 = u.pm * BM + wr * 64 + fr, col0 = u.pn * HALF + wc * 32 + 8 * fq;
#pragma unroll
        for (int ai = 0; ai < 2; ++ai)
#pragma unroll
            for (int m = 0; m < 4; ++m) { bf16* rowp = O + (size_t)(row0 + ai * HALF + m * 16) * ldc + col0;
                f32x4 v0, v1;
#pragma unroll
                for (int j = 0; j < 4; ++j) { v0[j] = silu_f(acc[ai][0][m][0][j]) * acc[ai][1][m][0][j]; v1[j] = silu_f(acc[ai][0][m][1][j]) * acc[ai][1][m][1][j]; }
                u32x4 w; w.x = cvt_pk(v0[0], v0[1]); w.y = cvt_pk(v0[2], v0[3]); w.z = cvt_pk(v1[0], v1[1]); w.w = cvt_pk(v1[2], v1[3]);
                *(u32x4*)rowp = w; }
    }
};
struct EpiSwigluF8 {
    static constexpr bool PERM = true, HAS_MID = false;
    unsigned char* O; int ldc; float descale;
    __device__ __forceinline__ void operator()(f32x4 (&acc)[2][2][4][2], const Unit& u, int wr, int wc, int fr, int fq) const {
        asm volatile("" : "+v"(fr), "+v"(fq));
        const int row0 = u.pm * BM + wr * 64 + fr, col0 = u.pn * HALF + wc * 32 + 8 * fq;
#pragma unroll
        for (int ai = 0; ai < 2; ++ai)
#pragma unroll
            for (int m = 0; m < 4; ++m) { unsigned char* rowp = O + (size_t)(row0 + ai * HALF + m * 16) * ldc + col0;
                f32x4 v0, v1;
#pragma unroll
                for (int j = 0; j < 4; ++j) { v0[j] = silu_f(acc[ai][0][m][0][j] * descale) * (acc[ai][1][m][0][j] * descale); v1[j] = silu_f(acc[ai][0][m][1][j] * descale) * (acc[ai][1][m][1][j] * descale); }
                u32x2 w; w.x = cvt4_fp8(v0[0], v0[1], v0[2], v0[3]); w.y = cvt4_fp8(v1[0], v1[1], v1[2], v1[3]);
                *(u32x2*)rowp = w; }
    }
};
struct EpiBf16Scale {
    static constexpr bool PERM = true, HAS_MID = false;
    bf16* O; int ldc; float descale;
    __device__ __forceinline__ void operator()(f32x4 (&acc)[2][2][4][2], const Unit& u, int wr, int wc, int fr, int fq) const {
        asm volatile("" : "+v"(fr), "+v"(fq));
        const int row0 = u.pm * BM + wr * 64 + fr, col0 = u.pn * BM + wc * 32 + 8 * fq;
#pragma unroll
        for (int ai = 0; ai < 2; ++ai)
#pragma unroll
            for (int m = 0; m < 4; ++m) { bf16* rowp = O + (size_t)(row0 + ai * HALF + m * 16) * ldc + col0;
#pragma unroll
                for (int bj = 0; bj < 2; ++bj) { const f32x4 v0 = acc[ai][bj][m][0] * descale, v1 = acc[ai][bj][m][1] * descale;
                    u32x4 w; w.x = cvt_pk(v0[0], v0[1]); w.y = cvt_pk(v0[2], v0[3]); w.z = cvt_pk(v1[0], v1[1]); w.w = cvt_pk(v1[2], v1[3]);
                    *(u32x4*)(rowp + bj * HALF) = w; } }
    }
};
struct EpiResid {
    static constexpr bool PERM = false, HAS_MID = false;
    const float* R; float* O; int ldc;
    __device__ __forceinline__ void operator()(f32x4 (&acc)[2][2][4][2], const Unit& u, int wr, int wc, int fr, int fq) const {
        asm volatile("" : "+v"(fr), "+v"(fq));
        const int row0 = u.pm * BM + wr * 64 + fr, col0 = u.pn * BM + wc * 32 + 4 * fq;
#pragma unroll
        for (int ai = 0; ai < 2; ++ai) {
            f32x4 r[4][2][2];
#pragma unroll
            for (int m = 0; m < 4; ++m) { const size_t off = (size_t)(row0 + ai * HALF + m * 16) * ldc + col0;
#pragma unroll
                for (int bj = 0; bj < 2; ++bj)
#pragma unroll
                    for (int n = 0; n < 2; ++n) r[m][bj][n] = *(const f32x4*)(R + off + bj * HALF + n * 16); }
#pragma unroll
            for (int m = 0; m < 4; ++m) { const size_t off = (size_t)(row0 + ai * HALF + m * 16) * ldc + col0;
#pragma unroll
                for (int bj = 0; bj < 2; ++bj)
#pragma unroll
                    for (int n = 0; n < 2; ++n) *(f32x4*)(O + off + bj * HALF + n * 16) = r[m][bj][n] + acc[ai][bj][m][n]; }
            asm volatile("" ::: "memory"); }
    }
};
struct EpiResidScale {
    static constexpr bool PERM = false, HAS_MID = false;
    const float* R; float* O; int ldc; float descale;
    __device__ __forceinline__ void operator()(f32x4 (&acc)[2][2][4][2], const Unit& u, int wr, int wc, int fr, int fq) const {
        asm volatile("" : "+v"(fr), "+v"(fq));
        const int row0 = u.pm * BM + wr * 64 + fr, col0 = u.pn * BM + wc * 32 + 4 * fq;
#pragma unroll
        for (int ai = 0; ai < 2; ++ai)
#pragma unroll
            for (int m = 0; m < 4; ++m) { const size_t off = (size_t)(row0 + ai * HALF + m * 16) * ldc + col0;
#pragma unroll
                for (int bj = 0; bj < 2; ++bj)
#pragma unroll
                    for (int n = 0; n < 2; ++n) { const f32x4 r = *(const f32x4*)(R + off + bj * HALF + n * 16); *(f32x4*)(O + off + bj * HALF + n * 16) = r + acc[ai][bj][m][n] * descale; }
                asm volatile("" ::: "memory"); }
    }
};
struct EpiMerge {
    static constexpr bool PERM = true, HAS_MID = true;
    const bf16* Gt; bf16* O;
    __device__ __forceinline__ int mid_branch(int kdone) const { return kdone == 512 ? 1 : (kdone == 1536 ? 2 : (kdone == 2048 ? 3 : 0)); }
    __device__ __forceinline__ void mid(f32x4 (&acc)[2][2][4][2], const Unit& u, int nb, int wr, int wc, int fr, int fq) const {
        asm volatile("" : "+v"(fr), "+v"(fq));
        const int row0 = u.pm * BM + wr * 64 + fr, col0 = u.pn * BM + wc * 32 + 8 * fq;
#pragma unroll
        for (int ai = 0; ai < 2; ++ai) {
            u32x4 ga_[4][2], gb_[4][2];
#pragma unroll
            for (int m = 0; m < 4; ++m) { const unsigned go = (unsigned)(row0 + ai * HALF + m * 16) * (unsigned)GW + (unsigned)col0 + (unsigned)(nb - 1) * 1024u;
#pragma unroll
                for (int bj = 0; bj < 2; ++bj) { ga_[m][bj] = *(const u32x4*)(Gt + (go + bj * HALF)); gb_[m][bj] = *(const u32x4*)(Gt + (go + 1024u + bj * HALF)); } }
#pragma unroll
            for (int m = 0; m < 4; ++m)
#pragma unroll
                for (int bj = 0; bj < 2; ++bj) { float ga[8], gb[8]; unpack8(ga_[m][bj], ga); unpack8(gb_[m][bj], gb);
#pragma unroll
                    for (int j = 0; j < 4; ++j) { acc[ai][bj][m][0][j] *= ga[j] * fast_rcp(gb[j]); acc[ai][bj][m][1][j] *= ga[4 + j] * fast_rcp(gb[4 + j]); } }
            asm volatile("" ::: "memory"); }
    }
    __device__ __forceinline__ void operator()(f32x4 (&acc)[2][2][4][2], const Unit& u, int wr, int wc, int fr, int fq) const {
        asm volatile("" : "+v"(fr), "+v"(fq));
        const int row0 = u.pm * BM + wr * 64 + fr, col0 = u.pn * BM + wc * 32 + 8 * fq;
#pragma unroll
        for (int ai = 0; ai < 2; ++ai) {
            u32x4 g3_[4][2];
#pragma unroll
            for (int m = 0; m < 4; ++m) { const unsigned r = (unsigned)(row0 + ai * HALF + m * 16);
#pragma unroll
                for (int bj = 0; bj < 2; ++bj) g3_[m][bj] = *(const u32x4*)(Gt + (r * (unsigned)GW + 3072u + (unsigned)col0 + bj * HALF)); }
#pragma unroll
            for (int m = 0; m < 4; ++m) { const unsigned r = (unsigned)(row0 + ai * HALF + m * 16);
#pragma unroll
                for (int bj = 0; bj < 2; ++bj) { float g[8]; unpack8(g3_[m][bj], g);
                    const f32x4 v0 = acc[ai][bj][m][0], v1 = acc[ai][bj][m][1];
                    u32x4 w; w.x = cvt_pk(v0[0] * g[0], v0[1] * g[1]); w.y = cvt_pk(v0[2] * g[2], v0[3] * g[3]); w.z = cvt_pk(v1[0] * g[4], v1[1] * g[5]); w.w = cvt_pk(v1[2] * g[6], v1[3] * g[7]);
                    *(u32x4*)(O + (r * (unsigned)D + (unsigned)col0 + bj * HALF)) = w; } }
            asm volatile("" ::: "memory"); }
    }
};

typedef int v8i __attribute__((ext_vector_type(8)));
typedef int u32x4i __attribute__((ext_vector_type(4)));
template <class Epi, class Sched, bool ALIGN_EPI, bool GATHER, int ESZ = 2>
__device__ __forceinline__ void gemm_phase(LAS unsigned char* lds, const int Kelem, const Sched& S, const Epi& E) {
    const int K = (ESZ == 2) ? Kelem : (Kelem >> 1);
    int tid_ = threadIdx.x; asm volatile("" : "+v"(tid_)); const int tid = tid_, wid = __builtin_amdgcn_readfirstlane(tid >> 6), lane = tid & 63, wr = wid >> 2, wc = wid & 3, fr = lane & 15, fq = lane >> 4;
    const int nt = K / BK;
    unsigned voffB[2], aoC[2][2], aoN[2][2];
#pragma unroll
    for (int i = 0; i < 2; ++i) { int R, C; stage_rc(tid * 16 + i * 8192, R, C); const int Rb = Epi::PERM ? ((R & ~31) + perm32(R & 31)) : R;
        voffB[i] = (unsigned)(Rb * K + C) * 2u;
#pragma unroll
        for (int h = 0; h < 2; ++h) { aoC[h][i] = (unsigned)((R + h * HALF) * K + C) * 2u; aoN[h][i] = aoC[h][i]; } }
    const size_t kstep = (size_t)(BK * 2);
    const size_t hstep = (size_t)HALF * K * 2;
    const size_t pstep = (size_t)64 * K * 2;
    const unsigned ldsw = (unsigned)wid * 1024u;
    const int aoff = lds_byte(wr * 64 + fr, fq * 8), boff = lds_byte(wc * 32 + fr, fq * 8);
#define PG8_SA(b, h) (((b) * 2 + (h)) * HTB)
#define PG8_SB(b, h) ((4 + (b) * 2 + (h)) * HTB)
#define PG8_STAGE(bufoff, gbase, voff) do { const char* _sb = (const char*)(gbase); asm volatile("" : "+s"(_sb)); _Pragma("unroll") for (int _i = 0; _i < 2; ++_i) \
        __builtin_amdgcn_global_load_lds((const unsigned*)(_sb + (voff)[_i]), (LAS unsigned*)(lds + (bufoff) + ldsw + _i * 8192), 16, 0, 0); } while (0)
#define PG8_STAGE1(bufoff, gbase, voff0) do { _Pragma("unroll") for (int _i = 0; _i < 2; ++_i) { const char* _sb = (const char*)(gbase) + (size_t)_i * pstep; asm volatile("" : "+s"(_sb)); \
        __builtin_amdgcn_global_load_lds((const unsigned*)(_sb + (voff0)), (LAS unsigned*)(lds + (bufoff) + ldsw + _i * 8192), 16, 0, 0); } } while (0)
#define PG8_STAGE_AC(bufoff, gbase, h) do { if constexpr (GATHER) PG8_STAGE(bufoff, gbase, aoC[h]); else PG8_STAGE1(bufoff, (const char*)(gbase) + (size_t)(h) * hstep, aoC[0][0]); } while (0)
#define PG8_STAGE_A2(bufoff, gbase, h) do { if constexpr (GATHER) { if (last) PG8_STAGE(bufoff, gbase, aoN[h]); else PG8_STAGE(bufoff, gbase, aoC[h]); } else PG8_STAGE1(bufoff, (const char*)(gbase) + (size_t)(h) * hstep, aoC[0][0]); } while (0)
#define PG8_LDA(dst, b, h) do { _Pragma("unroll") for (int m = 0; m < 4; ++m) _Pragma("unroll") for (int k = 0; k < 2; ++k) dst[m][k] = *(const LAS bf16x8*)(lds + PG8_SA(b, h) + aoff + m * 2048 + k * 1024); } while (0)
#define PG8_LDB(dst, b, h) do { _Pragma("unroll") for (int n = 0; n < 2; ++n) _Pragma("unroll") for (int k = 0; k < 2; ++k) dst[n][k] = *(const LAS bf16x8*)(lds + PG8_SB(b, h) + boff + n * 2048 + k * 1024); } while (0)
#define PG8_MMA(ai, bj, At, Bt) do { __builtin_amdgcn_s_setprio(1); _Pragma("unroll") for (int m = 0; m < 4; ++m) _Pragma("unroll") for (int n = 0; n < 2; ++n) _Pragma("unroll") for (int k = 0; k < 2; ++k) \
        acc[ai][bj][m][n] = __builtin_amdgcn_mfma_f32_16x16x32_bf16(Bt[n][k], At[m][k], acc[ai][bj][m][n], 0, 0, 0); __builtin_amdgcn_s_setprio(0); } while (0)
#define PG8_MMA8(ai, bj, A8, B8) do { __builtin_amdgcn_s_setprio(1); _Pragma("unroll") for (int m = 0; m < 4; ++m) _Pragma("unroll") for (int n = 0; n < 2; ++n) \
        acc[ai][bj][m][n] = __builtin_amdgcn_mfma_scale_f32_16x16x128_f8f6f4(B8[n], A8[m], acc[ai][bj][m][n], 0, 0, 0, one_scale, 0, one_scale); \
        asm volatile("" : "+v"(acc[ai][bj][0][0]), "+v"(acc[ai][bj][0][1]), "+v"(acc[ai][bj][1][0]), "+v"(acc[ai][bj][1][1]), "+v"(acc[ai][bj][2][0]), "+v"(acc[ai][bj][2][1]), "+v"(acc[ai][bj][3][0]), "+v"(acc[ai][bj][3][1])); \
        __builtin_amdgcn_s_setprio(0); } while (0)
#define PG8_LDA8(dst, b, h) do { _Pragma("unroll") for (int m = 0; m < 4; ++m) dst[m] = __builtin_shufflevector(*(const LAS u32x4i*)(lds + PG8_SA(b, h) + aoff + m * 2048), *(const LAS u32x4i*)(lds + PG8_SA(b, h) + aoff + m * 2048 + 1024), 0, 1, 2, 3, 4, 5, 6, 7); } while (0)
#define PG8_LDB8(dst, b, h) do { _Pragma("unroll") for (int n = 0; n < 2; ++n) dst[n] = __builtin_shufflevector(*(const LAS u32x4i*)(lds + PG8_SB(b, h) + boff + n * 2048), *(const LAS u32x4i*)(lds + PG8_SB(b, h) + boff + n * 2048 + 1024), 0, 1, 2, 3, 4, 5, 6, 7); } while (0)
#define PG8_MM(ai, bj, At, Bt) do { if constexpr (ESZ == 2) PG8_MMA(ai, bj, At, Bt); else PG8_MMA8(ai, bj, At##8, Bt##8); } while (0)
#define PG8_LA(dst, b, h) do { if constexpr (ESZ == 2) PG8_LDA(dst, b, h); else PG8_LDA8(dst##8, b, h); } while (0)
#define PG8_LB(dst, b, h) do { if constexpr (ESZ == 2) PG8_LDB(dst, b, h); else PG8_LDB8(dst##8, b, h); } while (0)
#define PG8_WAIT_V(n) asm volatile("s_waitcnt vmcnt(" #n ")" ::: "memory")
#define PG8_WAIT_L(n) asm volatile("s_waitcnt lgkmcnt(" #n ")" ::: "memory")
#define PG8_BAR __builtin_amdgcn_s_barrier()
#define PG8_SCHED __builtin_amdgcn_sched_barrier(0)
    int one_scale = 0x7f7f7f7f; asm volatile("" : "+v"(one_scale));
    Unit cur, nxt; int ui = 0;
    if (!S.next(0, cur)) return;
    if constexpr (GATHER) {
#pragma unroll
        for (int h = 0; h < 2; ++h)
#pragma unroll
            for (int i = 0; i < 2; ++i) { int R, C; stage_rc(tid * 16 + i * 8192, R, C); aoC[h][i] = (S.arow(cur, h * HALF + R) * (unsigned)K + (unsigned)C) * 2u; }
    }
    f32x4 acc[2][2][4][2];
#pragma unroll
    for (int a = 0; a < 2; ++a)
#pragma unroll
        for (int b = 0; b < 2; ++b)
#pragma unroll
            for (int m = 0; m < 4; ++m)
#pragma unroll
                for (int n = 0; n < 2; ++n) acc[a][b][m][n] = (f32x4){0.f, 0.f, 0.f, 0.f};
    bf16x8 At[4][2], B0[2][2], B1[2][2]; v8i At8[4], B08[2], B18[2];
    const char* cA = cur.a; const char* cB = cur.b;
    PG8_STAGE1(PG8_SB(0, 0), cB, voffB[0]); PG8_STAGE1(PG8_SB(0, 1), cB + hstep, voffB[0]); PG8_STAGE_AC(PG8_SA(0, 0), cA, 0); PG8_STAGE_AC(PG8_SA(0, 1), cA, 1);
    if (wr == 1) PG8_BAR;
    PG8_WAIT_V(2); PG8_BAR;
    PG8_STAGE1(PG8_SB(1, 0), cB + kstep, voffB[0]); PG8_STAGE_AC(PG8_SA(1, 0), cA + kstep, 0); PG8_STAGE1(PG8_SB(1, 1), cB + hstep + kstep, voffB[0]);
    PG8_WAIT_V(6); PG8_BAR;
    for (;;) {
        const bool has_next = S.next(ui + 1, nxt);
        const char* nA = has_next ? nxt.a : cA; const char* nB = has_next ? nxt.b : cB;
        if constexpr (GATHER) {
#pragma unroll
            for (int h = 0; h < 2; ++h)
#pragma unroll
                for (int i = 0; i < 2; ++i) { int R, C; stage_rc(tid * 16 + i * 8192, R, C); aoN[h][i] = has_next ? (S.arow(nxt, h * HALF + R) * (unsigned)K + (unsigned)C) * 2u : aoC[h][i]; }
        }
        for (int t = 0; t < nt; t += 2) {
            const bool last = (t == nt - 2);
            const char* a1 = cA + (size_t)(t + 1) * kstep;
            const char* a2 = last ? nA : cA + (size_t)(t + 2) * kstep; const char* b2 = last ? nB : cB + (size_t)(t + 2) * kstep;
            const char* a3 = a2 + kstep; const char* b3 = b2 + kstep;
            PG8_LB(B0, 0, 0); PG8_LB(B1, 0, 1); PG8_SCHED; PG8_LA(At, 0, 0); PG8_STAGE_AC(PG8_SA(1, 1), a1, 1);
            PG8_WAIT_V(8); PG8_WAIT_L(0); PG8_BAR; PG8_MM(0, 0, At, B0); PG8_MM(0, 1, At, B1); PG8_BAR; PG8_SCHED;
            PG8_LA(At, 0, 1); PG8_STAGE1(PG8_SB(0, 0), b2, voffB[0]); PG8_STAGE1(PG8_SB(0, 1), b2 + hstep, voffB[0]); PG8_STAGE_A2(PG8_SA(0, 0), a2, 0);
            PG8_WAIT_V(8); PG8_WAIT_L(0); PG8_BAR; PG8_MM(1, 0, At, B0); PG8_MM(1, 1, At, B1); PG8_BAR; PG8_SCHED;
            PG8_LB(B0, 1, 0); PG8_LB(B1, 1, 1); PG8_SCHED; PG8_LA(At, 1, 0); PG8_STAGE_A2(PG8_SA(0, 1), a2, 1);
            PG8_WAIT_V(8); PG8_WAIT_L(0); PG8_BAR; PG8_MM(0, 0, At, B0); PG8_MM(0, 1, At, B1); PG8_BAR; PG8_SCHED;
            PG8_LA(At, 1, 1); PG8_STAGE1(PG8_SB(1, 0), b3, voffB[0]); PG8_STAGE1(PG8_SB(1, 1), b3 + hstep, voffB[0]); PG8_STAGE_A2(PG8_SA(1, 0), a3, 0);
            PG8_WAIT_V(8); PG8_WAIT_L(0); PG8_BAR; PG8_MM(1, 0, At, B0); PG8_MM(1, 1, At, B1); PG8_BAR; PG8_SCHED;
            if constexpr (Epi::HAS_MID) { const int nb = E.mid_branch((t + 2) * BK); if (nb) { PG8_SCHED; E.mid(acc, cur, nb, wr, wc, fr, fq); PG8_SCHED; } }
        }
        if constexpr (ALIGN_EPI) { if (wr == 0) PG8_BAR; }
        E(acc, cur, wr, wc, fr, fq);
        if (!has_next) break;
#pragma unroll
        for (int a = 0; a < 2; ++a)
#pragma unroll
            for (int b = 0; b < 2; ++b)
#pragma unroll
                for (int m = 0; m < 4; ++m)
#pragma unroll
                    for (int n = 0; n < 2; ++n) acc[a][b][m][n] = (f32x4){0.f, 0.f, 0.f, 0.f};
        cur = nxt; cA = nA; cB = nB; ++ui;
        if constexpr (GATHER) {
#pragma unroll
            for (int h = 0; h < 2; ++h)
#pragma unroll
                for (int i = 0; i < 2; ++i) aoC[h][i] = aoN[h][i];
        }
        if constexpr (ALIGN_EPI) { if (wr == 1) PG8_BAR; }
    }
    PG8_WAIT_V(0);
    if constexpr (!ALIGN_EPI) { if (wr == 0) PG8_BAR; }
    PG8_BAR;
#undef PG8_SA
#undef PG8_SB
#undef PG8_STAGE
#undef PG8_STAGE1
#undef PG8_STAGE_A2
#undef PG8_STAGE_AC
#undef PG8_LDA
#undef PG8_LDB
#undef PG8_MMA
#undef PG8_MMA8
#undef PG8_MM
#undef PG8_LDA8
#undef PG8_LDB8
#undef PG8_LA
#undef PG8_LB
#undef PG8_WAIT_V
#undef PG8_WAIT_L
#undef PG8_BAR
#undef PG8_SCHED
}
}
struct Frame {
    LAS unsigned char* lds;
    volatile LAS unsigned* MISC;
    unsigned* ctl;
    unsigned char* ws;
    const float* const* in;
    float* out;
    int tid, lane, wave, G, bid;
};
#define WSP(T, off) ((T*)(F.ws + (off)))

__device__ __forceinline__ void tr_item(const float* src, int ldsrc, bf16* dst, int ldd, LAS float* scr, int lane) {
    const int kr = lane >> 3, n4 = 4 * (lane & 7);
    f32x4 v[16];
#pragma unroll
    for (int i = 0; i < 16; ++i) v[i] = *(const f32x4*)(src + (size_t)(8 * i + kr) * ldsrc + n4);
#pragma unroll
    for (int i = 0; i < 16; ++i) { LAS float* d = scr + (8 * i + kr) * 33 + n4; d[0] = v[i].x; d[1] = v[i].y; d[2] = v[i].z; d[3] = v[i].w; }
    LDS_WAIT(); asm volatile("" ::: "memory");
    const int c = lane & 7;
#pragma unroll
    for (int j = 0; j < 4; ++j) { const int n = (lane >> 3) + 8 * j; const LAS float* s = scr + (16 * c) * 33 + n;
        u32x4 o0, o1; o0.x = cvt_pk_bf16(s[0 * 33], s[1 * 33]); o0.y = cvt_pk_bf16(s[2 * 33], s[3 * 33]); o0.z = cvt_pk_bf16(s[4 * 33], s[5 * 33]); o0.w = cvt_pk_bf16(s[6 * 33], s[7 * 33]);
        o1.x = cvt_pk_bf16(s[8 * 33], s[9 * 33]); o1.y = cvt_pk_bf16(s[10 * 33], s[11 * 33]); o1.z = cvt_pk_bf16(s[12 * 33], s[13 * 33]); o1.w = cvt_pk_bf16(s[14 * 33], s[15 * 33]);
        u32x4* op = (u32x4*)(dst + (size_t)n * ldd + 16 * c); op[0] = o0; op[1] = o1; }
    LDS_WAIT(); asm volatile("" ::: "memory");
}
__device__ __forceinline__ void tr_item_f8(const float* src, int ldsrc, unsigned char* dst, int ldd, float scale, LAS float* scr, int lane) {
    const int kr = lane >> 3, n4 = 4 * (lane & 7);
    f32x4 v[16];
#pragma unroll
    for (int i = 0; i < 16; ++i) v[i] = *(const f32x4*)(src + (size_t)(8 * i + kr) * ldsrc + n4);
#pragma unroll
    for (int i = 0; i < 16; ++i) { LAS float* d = scr + (8 * i + kr) * 33 + n4; d[0] = v[i].x * scale; d[1] = v[i].y * scale; d[2] = v[i].z * scale; d[3] = v[i].w * scale; }
    LDS_WAIT(); asm volatile("" ::: "memory");
    const int c = lane & 7;
#pragma unroll
    for (int j = 0; j < 4; ++j) { const int n = (lane >> 3) + 8 * j; const LAS float* s = scr + (16 * c) * 33 + n;
        u32x4 o; o.x = cvt4_fp8(s[0 * 33], s[1 * 33], s[2 * 33], s[3 * 33]); o.y = cvt4_fp8(s[4 * 33], s[5 * 33], s[6 * 33], s[7 * 33]);
        o.z = cvt4_fp8(s[8 * 33], s[9 * 33], s[10 * 33], s[11 * 33]); o.w = cvt4_fp8(s[12 * 33], s[13 * 33], s[14 * 33], s[15 * 33]);
        *(u32x4*)(dst + (size_t)n * ldd + 16 * c) = o; }
    LDS_WAIT(); asm volatile("" ::: "memory");
}
__device__ __forceinline__ void tr_job_item(const float* src, int ldsrc, int sc0, int K, int N, bf16* dst, int ldd, int dr0, int dk0, int it, LAS float* scr, int lane) {
    const int nblk = N / 32, kb = it / nblk, nb = it % nblk;
    tr_item(src + (size_t)(128 * kb) * ldsrc + sc0 + 32 * nb, ldsrc, dst + (size_t)(dr0 + 32 * nb) * ldd + dk0 + 128 * kb, ldd, scr, lane);
}
__device__ __forceinline__ void tr_up_item(const float* wg, const float* wu, int FF, bf16* dst, int it, LAS float* scr, int lane) {
    const int nblk = 2 * FF / 32, kb = it / nblk, nb = it % nblk, r0 = 32 * nb, pn = r0 >> 8, s = (r0 >> 7) & 1, j = r0 & 127;
    const float* src = (s ? wu : wg) + (size_t)(128 * kb) * FF + 128 * pn + j;
    tr_item(src, FF, dst + (size_t)r0 * D + 128 * kb, D, scr, lane);
}
__device__ __forceinline__ void convert_layer_weights(Frame& F, int l, int gw, int NGW) {
    LAS float* scr = (LAS float*)(F.lds + F.wave * 16896);
    const float* w_in = F.in[2] + (size_t)l * D * 6160; const float* w_gate = F.in[3] + (size_t)l * D * 4096;
    bf16* W1T = WSP(bf16, WS_W1T) + (size_t)l * 10240 * D; bf16* BRT = WSP(bf16, WS_BRT) + (size_t)l * D * YW; bf16* OUTT = WSP(bf16, WS_OUTT) + (size_t)l * D * D;
    constexpr int I_A = 8 * (4608 / 32), I_B = 8 * (1536 / 32), I_G = 8 * (4096 / 32);
    constexpr int I_BA = 4 * 32, I_BB = 8 * 32, I_BC = 4 * 32, I_BD = 4 * 32, I_O = 8 * 32;
    constexpr int NIT = I_A + I_B + I_G + I_BA + I_BB + I_BC + I_BD + I_O;
    for (int it = gw; it < NIT; it += NGW) {
        int r = it; const float* src; int ldsrc, sc0, N; bf16* dst; int ldd, dr0, dk0;
        if (r < I_A) { src = w_in; ldsrc = 6160; sc0 = 0; N = 4608; dst = W1T; ldd = D; dr0 = 0; dk0 = 0; }
        else if ((r -= I_A) < I_B) { src = w_in; ldsrc = 6160; sc0 = 4624; N = 1536; dst = W1T; ldd = D; dr0 = 4608; dk0 = 0; }
        else if ((r -= I_B) < I_G) { src = w_gate; ldsrc = 4096; sc0 = 0; N = 4096; dst = W1T; ldd = D; dr0 = 6144; dk0 = 0; }
        else if ((r -= I_G) < I_BA) { src = F.in[17] + (size_t)l * 512 * D; ldsrc = D; sc0 = 0; N = D; dst = BRT; ldd = YW; dr0 = 0; dk0 = 0; }
        else if ((r -= I_BA) < I_BB) { src = F.in[18] + (size_t)l * 1024 * D; ldsrc = D; sc0 = 0; N = D; dst = BRT; ldd = YW; dr0 = 0; dk0 = 512; }
        else if ((r -= I_BB) < I_BC) { src = F.in[19] + (size_t)l * 512 * D; ldsrc = D; sc0 = 0; N = D; dst = BRT; ldd = YW; dr0 = 0; dk0 = 1536; }
        else if ((r -= I_BC) < I_BD) { src = F.in[20] + (size_t)l * 512 * D; ldsrc = D; sc0 = 0; N = D; dst = BRT; ldd = YW; dr0 = 0; dk0 = 2048; }
        else { r -= I_BD; src = F.in[21] + (size_t)l * D * D; ldsrc = D; sc0 = 0; N = D; dst = OUTT; ldd = D; dr0 = 0; dk0 = 0; }
        tr_job_item(src, ldsrc, sc0, 0, N, dst, ldd, dr0, dk0, r, scr, F.lane);
        asm volatile("" ::: "memory");
    }
    for (int it = gw; it < 4 * 4; it += NGW) { const int g = it >> 2, r = it & 3;
        tr_job_item(F.in[15] + ((size_t)l * 4 + g) * 128 * 128, 128, 0, 128, 128, WSP(bf16, WS_SMALL + SM_POOLT) + ((size_t)l * 4 + g) * 128 * 128, 128, 0, 0, r, scr, F.lane); }
    const int gt = gw * 64 + F.lane, NGT = NGW * 64;
    for (int i = gt; i < 4 * 128 * 128; i += NGT) { const int s = i & 127, t = (i >> 7) & 127; const float v = F.in[13][(size_t)l * 65536 + i];
        WSP(bf16, WS_SMALL + SM_GMW)[(size_t)l * 65536 + i] = f2bf(s <= t ? v : 0.f); }
    for (int i = gt; i < 16 * 1024; i += NGT) { const int k = i >> 4, j = i & 15; WSP(bf16, WS_SMALL + SM_WDT)[(size_t)l * 16384 + j * 1024 + k] = f2bf(w_in[(size_t)k * 6160 + 4608 + j]); }
}
__device__ __forceinline__ void convert_ffn_weights(Frame& F, int gw, int NGW) {
    LAS float* scr = (LAS float*)(F.lds + F.wave * 16896);
    constexpr int I_U = 8 * (2 * DFF / 32), I_D = (DFF / 128) * (D / 32);
    for (int it = gw; it < I_U + I_D; it += NGW) {
        if (it < I_U) tr_up_item(F.in[23], F.in[24], DFF, WSP(bf16, WS_UPT), it, scr, F.lane);
        else tr_job_item(F.in[25], D, 0, DFF, D, WSP(bf16, WS_DNT), DFF, 0, 0, it - I_U, scr, F.lane);
    }
}
__device__ __forceinline__ void convert_moe_weights(Frame& F, int gw, int NGW) {
    LAS float* scr = (LAS float*)(F.lds + F.wave * 16896);
    constexpr int NB_U = 2 * DFE / 32, I_U = (D / 128) * NB_U, NB_D = D / 32, I_D = (DFE / 128) * NB_D;
    for (int it = gw; it < NE * (I_U + I_D); it += NGW) {
        const int e = it / (I_U + I_D), r = it % (I_U + I_D);
        if (r < I_U) { const int kb = r / NB_U, nb = r % NB_U, r0 = 32 * nb, pn = r0 >> 8, sel = (r0 >> 7) & 1, j = r0 & 127;
            const float* src = (sel ? F.in[28] : F.in[27]) + (size_t)e * D * DFE + (size_t)(128 * kb) * DFE + 128 * pn + j;
            tr_item_f8(src, DFE, WSP(unsigned char, WS_MOEUP) + (size_t)e * 2 * DFE * D + (size_t)r0 * D + 128 * kb, D, MOE_UP_WSCALE, scr, F.lane); }
        else { const int q = r - I_U, kb = q / NB_D, nb = q % NB_D;
            const float* src = F.in[29] + (size_t)e * DFE * D + (size_t)(128 * kb) * D + 32 * nb;
            tr_item_f8(src, D, WSP(unsigned char, WS_MOEDN) + (size_t)e * D * DFE + (size_t)(32 * nb) * DFE + 128 * kb, DFE, MOE_DN_WSCALE, scr, F.lane); }
    }
}

__device__ __forceinline__ void rms_row(const float* xrow, const float* g, bf16* orow, int lane, f32x4 (&v)[4]) {
    const f32x4* xr = (const f32x4*)xrow + lane;
    float s = 0.f;
#pragma unroll
    for (int j = 0; j < 4; ++j) { v[j] = xr[64 * j]; s += (v[j].x * v[j].x + v[j].y * v[j].y) + (v[j].z * v[j].z + v[j].w * v[j].w); }
    const float r = 1.0f / sqrtf(wave_sum(s) * (1.f / D) + EPS);
    u32x2* o8 = (u32x2*)orow + lane;
#pragma unroll
    for (int j = 0; j < 4; ++j) { const f32x4 gv = ((const f32x4*)g)[64 * j + lane]; v[j] = v[j] * r * gv; u32x2 w; w.x = cvt_pk_bf16(v[j].x, v[j].y); w.y = cvt_pk_bf16(v[j].z, v[j].w); o8[64 * j] = w; }
}
__device__ __forceinline__ void rms_row_f8(const float* xrow, const float* g, unsigned char* orow, int lane, f32x4 (&v)[4]) {
    const f32x4* xr = (const f32x4*)xrow + lane;
    float s = 0.f;
#pragma unroll
    for (int j = 0; j < 4; ++j) { v[j] = xr[64 * j]; s += (v[j].x * v[j].x + v[j].y * v[j].y) + (v[j].z * v[j].z + v[j].w * v[j].w); }
    const float r = 1.0f / sqrtf(wave_sum(s) * (1.f / D) + EPS);
    unsigned* o4 = (unsigned*)orow + lane;
#pragma unroll
    for (int j = 0; j < 4; ++j) { const f32x4 gv = ((const f32x4*)g)[64 * j + lane]; v[j] = v[j] * r * gv; o4[64 * j] = cvt4_fp8(v[j].x, v[j].y, v[j].z, v[j].w); }
}
__device__ __forceinline__ void rmsnorm_phase(Frame& F, const float* x, const float* g, bf16* out) {
    const int gw = F.bid * NWAVES + F.wave, NGW = F.G * NWAVES;
    for (int m = gw; m < L; m += NGW) { f32x4 v[4]; rms_row(x + (size_t)m * D, g, out + (size_t)m * D, F.lane, v); }
}

__device__ __forceinline__ void rmsnorm_phase_f8(Frame& F, const float* x, const float* g, unsigned char* out) {
    const int gw = F.bid * NWAVES + F.wave, NGW = F.G * NWAVES;
    for (int m = gw; m < L; m += NGW) { f32x4 v[4]; rms_row_f8(x + (size_t)m * D, g, out + (size_t)m * D, F.lane, v); }
}
__device__ __forceinline__ void route_phase(Frame& F, const float* x, const float* g, unsigned char* out, const float* rw) {
    LAS float* RW = (LAS float*)F.lds;
    LAS int* HC = (LAS int*)(F.lds + 32768);
    for (int i = F.tid; i < 8192; i += NTHR) RW[(i & 7) * 1024 + (i >> 3)] = rw[i];
    if (F.tid < 8) HC[F.tid] = 0;
    __syncthreads();
    unsigned* topk = WSP(unsigned, WS_ROUTE + RT_TOPK);
    for (int rr = 0; rr < 8; ++rr) {
        const int t = F.bid * 64 + F.wave * 8 + rr;
        f32x4 v[4]; rms_row_f8(x + (size_t)t * D, g, out + (size_t)t * D, F.lane, v);
        float lg[8];
#pragma unroll
        for (int e = 0; e < 8; ++e) lg[e] = 0.f;
#pragma unroll
        for (int j = 0; j < 4; ++j)
#pragma unroll
            for (int e = 0; e < 8; ++e) { const f32x4 w = *(const LAS f32x4*)(RW + e * 1024 + 4 * (64 * j + F.lane)); lg[e] += (v[j].x * w.x + v[j].y * w.y) + (v[j].z * w.z + v[j].w * w.w); }
#pragma unroll
        for (int e = 0; e < 8; ++e) lg[e] = wave_sum(lg[e]);
        int i0 = 0; float m0 = lg[0];
#pragma unroll
        for (int e = 1; e < 8; ++e) if (lg[e] > m0) { m0 = lg[e]; i0 = e; }
        int i1 = -1; float m1 = -3.0e38f;
#pragma unroll
        for (int e = 0; e < 8; ++e) if (e != i0 && lg[e] > m1) { m1 = lg[e]; i1 = e; }
        const float e1 = expf(m1 - m0), den = 1.f + e1;
        if (F.lane == 0) { u32x4 o; o.x = (unsigned)i0; o.y = (unsigned)i1; o.z = __float_as_uint(1.f / den); o.w = __float_as_uint(e1 / den); *(u32x4*)(topk + 4 * t) = o;
            atomicAdd((int*)&HC[i0], 1); atomicAdd((int*)&HC[i1], 1); }
    }
    __syncthreads();
    if (F.tid < 8) WSP(int, WS_ROUTE + RT_CNT)[F.bid * 8 + F.tid] = HC[F.tid];
}
__device__ __forceinline__ void assign_phase(Frame& F) {
    LAS int* SB = (LAS int*)F.lds;
    const int* cnt = WSP(int, WS_ROUTE + RT_CNT);
    const unsigned* topk = WSP(unsigned, WS_ROUTE + RT_TOPK);
    int* rowidx = WSP(int, WS_ROUTE + RT_ROWIDX); int* tokslot = WSP(int, WS_ROUTE + RT_TOKSLOT);
    if (F.tid < 8) { int before = 0, tot = 0; for (int b = 0; b < F.G; ++b) { const int c = cnt[b * 8 + F.tid]; tot += c; if (b < F.bid) before += c; } SB[F.tid] = before; SB[16 + F.tid] = tot; }
    __syncthreads();
    if (F.tid == 0) { int off = 0; for (int e = 0; e < 8; ++e) { SB[8 + e] = off; off += (SB[16 + e] + 255) & ~255; } SB[24] = off; }
    __syncthreads();
    if (F.tid < 8) { const int e = F.tid; int run = SB[8 + e] + SB[e];
        for (int i = 0; i < 64; ++i) { const int t = F.bid * 64 + i; const unsigned e0 = topk[4 * t], e1 = topk[4 * t + 1];
            if ((int)e0 == e) { rowidx[run] = t; tokslot[2 * t] = run; ++run; }
            if ((int)e1 == e) { rowidx[run] = t; tokslot[2 * t + 1] = run; ++run; } } }
    if (F.bid < 8) { const int e = F.bid, lo = SB[8 + e] + SB[16 + e], hi = SB[8 + e] + ((SB[16 + e] + 255) & ~255); for (int s = lo + F.tid; s < hi; s += NTHR) rowidx[s] = 0; }
    if (F.bid == 0) { int* tile_e = WSP(int, WS_ROUTE + RT_TILEE); const int nt = SB[24] >> 8;
        for (int i = F.tid; i < nt; i += NTHR) { int e = 0; for (int q = 1; q < 8; ++q) if (i * 256 >= SB[8 + q]) e = q; tile_e[i] = e; }
        if (F.tid == 0) WSP(int, WS_ROUTE + RT_NT)[0] = nt; }
}
struct MoeUpSched {
    pg8::TileOrder o; const char* A; const char* Bt; const int* tile_e; const int* rowidx;
    __device__ __forceinline__ bool next(int i, pg8::Unit& u) const { if (!o.tile(i, u.pm, u.pn)) return false; const int e = __builtin_amdgcn_readfirstlane(tile_e[u.pm]); u.a = A; u.b = Bt + ((size_t)e * 2 * DFE + (size_t)u.pn * 256) * D; return true; }
    __device__ __forceinline__ unsigned arow(const pg8::Unit& u, int r) const { return (unsigned)rowidx[u.pm * 256 + r]; }
};
struct MoeDnSched {
    pg8::TileOrder o; const char* A; const char* Bt; const int* tile_e;
    __device__ __forceinline__ bool next(int i, pg8::Unit& u) const { if (!o.tile(i, u.pm, u.pn)) return false; const int e = __builtin_amdgcn_readfirstlane(tile_e[u.pm]); u.a = A + (size_t)u.pm * 256 * DFE; u.b = Bt + ((size_t)e * D + (size_t)u.pn * 256) * DFE; return true; }
    __device__ __forceinline__ unsigned arow(const pg8::Unit&, int) const { return 0u; }
};
__device__ __forceinline__ void final_phase(Frame& F, const float* x, const bf16* ybuf, const float* g, float* out) {
    const int gw = F.bid * NWAVES + F.wave, NGW = F.G * NWAVES;
    const unsigned* topk = WSP(unsigned, WS_ROUTE + RT_TOPK); const int* tokslot = WSP(int, WS_ROUTE + RT_TOKSLOT);
    for (int t = gw; t < L; t += NGW) {
        const float g0 = __uint_as_float(topk[4 * t + 2]), g1 = __uint_as_float(topk[4 * t + 3]); const int s0 = tokslot[2 * t], s1 = tokslot[2 * t + 1];
        const f32x4* xr = (const f32x4*)(x + (size_t)t * D) + F.lane; const u32x2* y0 = (const u32x2*)(ybuf + (size_t)s0 * D) + F.lane; const u32x2* y1 = (const u32x2*)(ybuf + (size_t)s1 * D) + F.lane;
        f32x4 v[4]; float s = 0.f;
#pragma unroll
        for (int j = 0; j < 4; ++j) { const u32x2 a = y0[64 * j], b = y1[64 * j]; v[j] = xr[64 * j];
            v[j].x += g0 * bflo(a.x) + g1 * bflo(b.x); v[j].y += g0 * bfhi(a.x) + g1 * bfhi(b.x); v[j].z += g0 * bflo(a.y) + g1 * bflo(b.y); v[j].w += g0 * bfhi(a.y) + g1 * bfhi(b.y);
            s += (v[j].x * v[j].x + v[j].y * v[j].y) + (v[j].z * v[j].z + v[j].w * v[j].w); }
        const float r = 1.0f / sqrtf(wave_sum(s) * (1.f / D) + EPS);
        f32x4* o = (f32x4*)(out + (size_t)t * D) + F.lane;
#pragma unroll
        for (int j = 0; j < 4; ++j) o[64 * j] = v[j] * r * ((const f32x4*)g)[64 * j + F.lane];
    }
}
#ifndef DIAGSET
#define DIAGSET 0
#endif
#ifndef DIAGK
#define DIAGK 8
#endif
#define DG_ON (DIAGSET != 0)
#define DG_T0 (*(volatile LAS unsigned long long*)(F.lds + MISC_OFF + 64))
#define DG_ACC (*(volatile LAS unsigned long long*)(F.lds + MISC_OFF + 72))
#define DG_START() do { if (DG_ON && F.bid == 0 && threadIdx.x == 0) DG_T0 = __builtin_amdgcn_s_memrealtime(); } while (0)
#define DG_STOP(k) do { if (DG_ON && ((DIAGSET >> (k)) & 1) && F.bid == 0 && threadIdx.x == 0) DG_ACC = DG_ACC + (__builtin_amdgcn_s_memrealtime() - DG_T0); } while (0)
__device__ __forceinline__ u32x4 ld16(const bf16* p) { return *(const u32x4*)p; }
__device__ __forceinline__ u32x2 ld8(const bf16* p) { return *(const u32x2*)p; }

__device__ __forceinline__ void mixer_a(Frame& F, int l, int b) {
    const bf16* P = WSP(bf16, WS_PROJ); bf16* Y = WSP(bf16, WS_YCAT); const float* cw = F.in[4] + (size_t)l * 3 * 512;
    const int c0 = 8 * F.lane, tb = 64 * b + 8 * F.wave;
    float w0[8], w1[8], w2[8];
#pragma unroll
    for (int j = 0; j < 8; ++j) { w0[j] = cw[c0 + j]; w1[j] = cw[512 + c0 + j]; w2[j] = cw[1024 + c0 + j]; }
    float pm2[8], pm1[8];
#pragma unroll
    for (int r = -2; r < 8; ++r) {
        const int t = tb + r; float pr[8];
        if (t >= 0) { float ah[8], ac[8]; unpack8(ld16(P + (size_t)t * PW + c0), ah); unpack8(ld16(P + (size_t)t * PW + 1024 + c0), ac);
#pragma unroll
            for (int j = 0; j < 8; ++j) pr[j] = ah[j] * ac[j]; }
        else {
#pragma unroll
            for (int j = 0; j < 8; ++j) pr[j] = 0.f; }
        if (r >= 0) { float ab[8], o[8]; unpack8(ld16(P + (size_t)t * PW + 512 + c0), ab);
#pragma unroll
            for (int j = 0; j < 8; ++j) o[j] = ab[j] * (w0[j] * pm2[j] + w1[j] * pm1[j] + w2[j] * pr[j]);
            *(u32x4*)(Y + (size_t)t * YW + c0) = pack8(o); }
#pragma unroll
        for (int j = 0; j < 8; ++j) { pm2[j] = pm1[j]; pm1[j] = pr[j]; }
    }
}

__device__ __forceinline__ void mixer_d(Frame& F, int l, int b) {
    const bf16* P = WSP(bf16, WS_PROJ); bf16* Y = WSP(bf16, WS_YCAT);
    LAS unsigned char* RAW = F.lds;
    LAS unsigned char* PL = F.lds + 21504;
    const int t0 = 64 * b, fr = F.lane & 15, fq = F.lane >> 4;
    for (int g = 0; g < 4; ++g) {
        const int win = 2 << g;
        for (int i = F.tid; i < 79 * 16; i += NTHR) { const int r = i >> 4, c8 = i & 15, t = t0 - 15 + r;
            u32x4 v = (u32x4){0u, 0u, 0u, 0u}; if (t >= 0) v = ld16(P + (size_t)t * PW + 5632 + g * 128 + 8 * c8);
            *(LAS u32x4*)(RAW + r * 272 + c8 * 16) = v; }
        __syncthreads();
        for (int i = F.tid; i < 64 * 16; i += NTHR) { const int r = i >> 4, c8 = i & 15, t = t0 + r;
            float s[8], x0[8];
#pragma unroll
            for (int j = 0; j < 8; ++j) s[j] = 0.f;
            for (int k = 0; k < win; ++k) { float x[8]; unpack8(*(const LAS u32x4*)(RAW + (r + 15 - k) * 272 + c8 * 16), x);
#pragma unroll
                for (int j = 0; j < 8; ++j) s[j] += x[j];
                if (k == 0) {
#pragma unroll
                    for (int j = 0; j < 8; ++j) x0[j] = x[j]; } }
            const float inv = 1.0f / (float)((t + 1 < win) ? t + 1 : win);
#pragma unroll
            for (int j = 0; j < 8; ++j) s[j] = s[j] * inv - x0[j];
            *(LAS u32x4*)(PL + r * 272 + c8 * 16) = pack8(s); }
        __syncthreads();
        const bf16* Q = WSP(bf16, WS_SMALL + SM_POOLT) + ((size_t)l * 4 + g) * 128 * 128 + (size_t)(16 * F.wave + fr) * 128 + 8 * fq;
        f32x4 acc[4];
#pragma unroll
        for (int m = 0; m < 4; ++m) acc[m] = (f32x4){0.f, 0.f, 0.f, 0.f};
#pragma unroll
        for (int kk = 0; kk < 4; ++kk) { const bf16x8 q = gfrag(Q + 32 * kk);
#pragma unroll
            for (int m = 0; m < 4; ++m) { const bf16x8 p = ldsfrag(PL, (16 * m + fr) * 272 + (32 * kk + 8 * fq) * 2); MMA16(acc[m], q, p); } }
        const int d0 = 16 * F.wave + 4 * fq; const f32x4 sc = *(const f32x4*)(F.in[16] + (size_t)l * 512 + g * 128 + d0);
#pragma unroll
        for (int m = 0; m < 4; ++m) { const f32x4 v = acc[m] * sc; u32x2 w; w.x = cvt_pk_bf16(v[0], v[1]); w.y = cvt_pk_bf16(v[2], v[3]);
            *(u32x2*)(Y + (size_t)(t0 + 16 * m + fr) * YW + 2048 + g * 128 + d0) = w; }
        __syncthreads();
    }
}

__device__ __forceinline__ void mixer_c(Frame& F, int l, int blk, int gp) {
    const bf16* P = WSP(bf16, WS_PROJ); bf16* Y = WSP(bf16, WS_YCAT);
    LAS float* MU = (LAS float*)F.lds; LAS float* RS = (LAS float*)(F.lds + 512); LAS unsigned char* VR = F.lds + 1024;
    const int t0 = 128 * blk, fr = F.lane & 15, fq = F.lane >> 4;
    for (int i = 0; i < 16; ++i) { const int row = 16 * F.wave + i; float x[8]; unpack8(ld16(P + (size_t)(t0 + row) * PW + 5120 + 8 * F.lane), x);
        float s = 0.f, q = 0.f;
#pragma unroll
        for (int j = 0; j < 8; ++j) { s += x[j]; q += x[j] * x[j]; }
        s = wave_sum(s); q = wave_sum(q);
        if (F.lane == 0) { const float mu = s * (1.f / 512.f); const float var = fmaxf(q * (1.f / 512.f) - mu * mu, 0.f); MU[row] = mu; RS[row] = 1.0f / sqrtf(var + EPS); } }
    __syncthreads();
    { const int ch8 = F.lane & 31, par = F.lane >> 5, cv = gp * 256 + 8 * ch8;
      float lg[8], lb[8];
#pragma unroll
      for (int j = 0; j < 8; ++j) { lg[j] = F.in[11][(size_t)l * 512 + cv + j]; lb[j] = F.in[12][(size_t)l * 512 + cv + j]; }
      for (int i = 0; i < 8; ++i) { const int row = 16 * F.wave + 2 * i + par; float x[8]; unpack8(ld16(P + (size_t)(t0 + row) * PW + 5120 + cv), x);
          const float mu = MU[row], rs = RS[row];
#pragma unroll
          for (int j = 0; j < 8; ++j) x[j] = (x[j] - mu) * rs * lg[j] + lb[j];
          *(LAS u32x4*)(VR + row * 528 + 16 * ch8) = pack8(x); } }
    __syncthreads();
    const int g = 2 * gp + (F.wave >> 2);
    const bf16* Wm = WSP(bf16, WS_SMALL + SM_GMW) + ((size_t)l * 4 + g) * 128 * 128;
    f32x4 acc[8][2];
#pragma unroll
    for (int m = 0; m < 8; ++m) { acc[m][0] = (f32x4){0.f, 0.f, 0.f, 0.f}; acc[m][1] = (f32x4){0.f, 0.f, 0.f, 0.f}; }
#pragma unroll
    for (int m = 0; m < 8; ++m) {
#pragma unroll
        for (int kk = 0; kk < 4; ++kk) if (kk <= (m >> 1)) { const bf16x8 p = gfrag(Wm + (size_t)(16 * m + fr) * 128 + 32 * kk + 8 * fq);
#pragma unroll
            for (int x = 0; x < 2; ++x) { const bf16x8 q = ldsfrag_tr(VR, 528, 32 * kk, 16 * (2 * F.wave + x), fr, fq); MMA16(acc[m][x], q, p); } } }
#pragma unroll
    for (int m = 0; m < 8; ++m) { const int tl = 16 * m + fr; const float bias = F.in[14][((size_t)l * 4 + g) * 128 + tl];
#pragma unroll
        for (int x = 0; x < 2; ++x) { const int cl = 16 * ((2 * F.wave + x) & 7) + 4 * fq; const u32x2 u = ld8(P + (size_t)(t0 + tl) * PW + 4608 + g * 128 + cl);
            const f32x4 a = acc[m][x]; u32x2 w; w.x = cvt_pk_bf16(bflo(u.x) * (a[0] + bias), bfhi(u.x) * (a[1] + bias)); w.y = cvt_pk_bf16(bflo(u.y) * (a[2] + bias), bfhi(u.y) * (a[3] + bias));
            *(u32x2*)(Y + (size_t)(t0 + tl) * YW + 1536 + g * 128 + cl) = w; } }
    __syncthreads();
}

constexpr int S1_DTV = 0, S1_DAC = 4096, S1_WV = 8192, S1_RED = 12288, S1_CL = 12288, S1_BL = 29696, S1_XR = 47104, S1_SH = 80896, XRP = 528;
template <int MODE = 0> __device__ __forceinline__ void ssd1_chunk(Frame& F, int l, int c) {
    const bf16* P = WSP(bf16, WS_PROJ); bf16* Y = WSP(bf16, WS_YCAT); const bf16* H = WSP(bf16, WS_H);
    LAS unsigned char* lds = F.lds; LAS float* DTV = (LAS float*)(lds + S1_DTV); LAS float* DAC = (LAS float*)(lds + S1_DAC); LAS float* WV = (LAS float*)(lds + S1_WV); LAS float* RED = (LAS float*)(lds + S1_RED);
    const int t0 = 64 * c, fr = F.lane & 15, fq = F.lane >> 4, wave = F.wave, lane = F.lane;
#ifdef SSD1PROBE
#define SP_START() DG_START()
#define SP_STOP(k) DG_STOP(k)
#else
#define SP_START()
#define SP_STOP(k)
#endif
    SP_START();
    { f32x4 acc[4];
#pragma unroll
      for (int m = 0; m < 4; ++m) acc[m] = (f32x4){0.f, 0.f, 0.f, 0.f};
      const bf16* Hp = H + (size_t)(t0 + fr) * D + wave * 128 + 8 * fq; const bf16* Wd = WSP(bf16, WS_SMALL + SM_WDT) + (size_t)l * 16384 + fr * 1024 + wave * 128 + 8 * fq;
#pragma unroll
      for (int kk = 0; kk < 4; ++kk) { const bf16x8 q = gfrag(Wd + 32 * kk);
#pragma unroll
          for (int m = 0; m < 4; ++m) { const bf16x8 p = gfrag(Hp + (size_t)(16 * m) * D + 32 * kk); MMA16(acc[m], q, p); } }
#pragma unroll
      for (int m = 0; m < 4; ++m) *(LAS f32x4*)(RED + (wave * 64 + 16 * m + fr) * 16 + 4 * fq) = acc[m]; }
    __syncthreads();
    for (int o = F.tid; o < 1024; o += NTHR) { float s = 0.f;
#pragma unroll
        for (int w = 0; w < 8; ++w) s += RED[w * 1024 + o];
        const int j = o & 15, tt = o >> 4; const float dt = softplus_f(s + F.in[7][l * 16 + j]); DTV[j * 64 + tt] = dt; DAC[j * 64 + tt] = -expf(F.in[8][l * 16 + j]) * dt; }
    __syncthreads();
    if (F.tid < 16) { float run = 0.f; for (int t = 0; t < 64; ++t) { run += DAC[F.tid * 64 + t]; DAC[F.tid * 64 + t] = run; } }
    __syncthreads();
    for (int o = F.tid; o < 1024; o += NTHR) { const int j = o & 15, tt = o >> 4, q = j * 64 + tt; WV[q] = DTV[q] * expf(DAC[j * 64 + 63] - DAC[q]); WSP(float, WS_DACS)[(size_t)t0 * 16 + o] = DAC[q]; }
    __syncthreads();
    SP_STOP(27);
    if (MODE == 1) return;
    for (int g = 0; g < 4; ++g) {
        SP_START();
        { const int chx = lane < 32 ? g * 256 + 8 * lane : (lane < 48 ? 1024 + g * 128 + 8 * (lane - 32) : 1536 + g * 128 + 8 * (lane - 48));
          const float* cw = F.in[5] + (size_t)l * 4 * 2048 + chx; const float* cb = F.in[6] + (size_t)l * 2048 + chx;
          float w0[8], w1[8], w2[8], w3[8], bi[8];
#pragma unroll
          for (int j = 0; j < 8; ++j) { w0[j] = cw[j]; w1[j] = cw[2048 + j]; w2[j] = cw[4096 + j]; w3[j] = cw[6144 + j]; bi[j] = cb[j]; }
          u32x4 raw[11];
#pragma unroll
          for (int r = 0; r < 11; ++r) { const int t = t0 + 8 * wave + r - 3; raw[r] = (u32x4){0u, 0u, 0u, 0u}; if (t >= 0) raw[r] = ld16(P + (size_t)t * PW + 2560 + chx); }
          float x3[8], x2[8], x1[8]; unpack8(raw[0], x3); unpack8(raw[1], x2); unpack8(raw[2], x1);
#pragma unroll
          for (int r = 0; r < 8; ++r) { float x0[8], o[8]; unpack8(raw[3 + r], x0); const int row = 8 * wave + r;
#pragma unroll
              for (int j = 0; j < 8; ++j) { o[j] = silu_f(bi[j] + w0[j] * x3[j] + w1[j] * x2[j] + w2[j] * x1[j] + w3[j] * x0[j]); x3[j] = x2[j]; x2[j] = x1[j]; x1[j] = x0[j]; }
              const u32x4 pk = pack8(o);
              if (lane >= 48) { const int n0 = 8 * (lane - 48); *(LAS u32x4*)(lds + S1_CL + row * 272 + n0 * 2) = pk; *(u32x4*)(WSP(bf16, WS_CC) + (size_t)(t0 + row) * 512 + g * 128 + n0) = pk; }
              else if (lane >= 32) { *(LAS u32x4*)(lds + S1_BL + row * 272 + 16 * (lane - 32)) = pk; }
              else { *(LAS u32x4*)(lds + S1_XR + row * XRP + 16 * lane) = pk; } } }
        __syncthreads();
        SP_STOP(28); SP_START();
        if (MODE == 2) { __syncthreads(); continue; }
        { const int mi = wave >> 1, nb = (wave & 1) * 2;
          f32x4 cbv[2] = {(f32x4){0.f, 0.f, 0.f, 0.f}, (f32x4){0.f, 0.f, 0.f, 0.f}};
#pragma unroll
          for (int kk = 0; kk < 4; ++kk) { const bf16x8 p = ldsfrag(lds, S1_CL + (16 * mi + fr) * 272 + (32 * kk + 8 * fq) * 2);
#pragma unroll
              for (int x = 0; x < 2; ++x) if (nb + x <= mi) { const bf16x8 q = ldsfrag(lds, S1_BL + (16 * (nb + x) + fr) * 272 + (32 * kk + 8 * fq) * 2); MMA16(cbv[x], q, p); } }
          const int lrow = 16 * mi + fr;
#pragma unroll
          for (int hl = 0; hl < 4; ++hl) { const int hh = 4 * g + hl; const float dl = DAC[hh * 64 + lrow];
#pragma unroll
              for (int x = 0; x < 2; ++x) { const int s0 = 16 * (nb + x) + 4 * fq; float v[4];
#pragma unroll
                  for (int r = 0; r < 4; ++r) { const int s = s0 + r; const bool ok = (nb + x <= mi) && (s <= lrow); const float e = ok ? fast_exp(fminf(dl - DAC[hh * 64 + s], 0.f)) * DTV[hh * 64 + s] : 0.f; v[r] = ok ? cbv[x][r] * e : 0.f; }
                  u32x2 w; w.x = cvt_pk_bf16(v[0], v[1]); w.y = cvt_pk_bf16(v[2], v[3]);
                  *(LAS u32x2*)(lds + S1_SH + ((hl * 64 + lrow) * 72 + s0) * 2) = w; } } }
        __syncthreads();
        SP_STOP(29); SP_START();
        { const int hl = wave >> 1, hh = 4 * g + hl;
          const float dsk = F.in[9][l * 16 + hh];
#pragma unroll
          for (int m2 = 0; m2 < 2; ++m2) { const int mi = 2 * (wave & 1) + m2, nk = (mi >> 1) + 1;
              f32x4 y[4];
#pragma unroll
              for (int pi = 0; pi < 4; ++pi) y[pi] = (f32x4){0.f, 0.f, 0.f, 0.f};
#pragma unroll
              for (int kk = 0; kk < 2; ++kk) if (kk < nk) { const bf16x8 p = ldsfrag(lds, S1_SH + ((hl * 64 + 16 * mi + fr) * 72 + 32 * kk + 8 * fq) * 2);
#pragma unroll
                  for (int pi = 0; pi < 4; ++pi) { const bf16x8 q = ldsfrag_tr(lds + S1_XR, XRP, 32 * kk, hl * 64 + 16 * pi, fr, fq); MMA16(y[pi], q, p); } }
              const int lrow = 16 * mi + fr;
#pragma unroll
              for (int pi = 0; pi < 4; ++pi) { const int p0 = 16 * pi + 4 * fq; float xs[4];
                  { const u32x2 xr = *(const LAS u32x2*)(lds + S1_XR + lrow * XRP + (hl * 64 + p0) * 2); xs[0] = bflo(xr.x); xs[1] = bfhi(xr.x); xs[2] = bflo(xr.y); xs[3] = bfhi(xr.y); }
                  u32x2 w; w.x = cvt_pk_bf16(y[pi][0] + dsk * xs[0], y[pi][1] + dsk * xs[1]); w.y = cvt_pk_bf16(y[pi][2] + dsk * xs[2], y[pi][3] + dsk * xs[3]);
                  *(u32x2*)(Y + (size_t)(t0 + lrow) * YW + 512 + hh * 64 + p0) = w; } }
          f32x4 st[4][4];
#pragma unroll
          for (int pi = 0; pi < 4; ++pi)
#pragma unroll
              for (int nx = 0; nx < 4; ++nx) st[pi][nx] = (f32x4){0.f, 0.f, 0.f, 0.f};
#pragma unroll
          for (int kk = 0; kk < 2; ++kk) { float wv[8];
              { const f32x4 wa = *(const LAS f32x4*)(WV + hh * 64 + 32 * kk + 8 * fq), wb = *(const LAS f32x4*)(WV + hh * 64 + 32 * kk + 8 * fq + 4); wv[0] = wa[0]; wv[1] = wa[1]; wv[2] = wa[2]; wv[3] = wa[3]; wv[4] = wb[0]; wv[5] = wb[1]; wv[6] = wb[2]; wv[7] = wb[3]; }
              bf16x8 pa[4];
#pragma unroll
              for (int pi = 0; pi < 4; ++pi) { float xv[8]; unpack8(__builtin_bit_cast(u32x4, ldsfrag_tr(lds + S1_XR, XRP, 32 * kk, hl * 64 + 16 * pi, fr, fq)), xv);
#pragma unroll
                  for (int j = 0; j < 8; ++j) xv[j] *= wv[j];
                  const u32x4 pk = pack8(xv); pa[pi] = __builtin_bit_cast(bf16x8, pk); }
#pragma unroll
              for (int nx = 0; nx < 4; ++nx) { const bf16x8 q = ldsfrag_tr(lds + S1_BL, 272, 32 * kk, 16 * (4 * (wave & 1) + nx), fr, fq);
#pragma unroll
                  for (int pi = 0; pi < 4; ++pi) MMA16(st[pi][nx], q, pa[pi]); } }
          bf16* ST = WSP(bf16, WS_STATES) + ((size_t)c * 16 + hh) * 8192;
#pragma unroll
          for (int pi = 0; pi < 4; ++pi)
#pragma unroll
              for (int nx = 0; nx < 4; ++nx) { const f32x4 v = st[pi][nx]; u32x2 w; w.x = cvt_pk_bf16(v[0], v[1]); w.y = cvt_pk_bf16(v[2], v[3]);
                  *(u32x2*)(ST + (size_t)(16 * pi + fr) * 128 + 16 * (4 * (wave & 1) + nx) + 4 * fq) = w; } }
        __syncthreads();
        SP_STOP(30);
    }
}

template <bool DUMMY = false> __device__ __forceinline__ void scan_phase(Frame& F) {
    const int e = F.bid * NTHR + F.tid, hh = e >> 13;
    bf16* ST = WSP(bf16, WS_STATES) + e; const float* DA = WSP(float, WS_DACS) + 63 * 16 + hh;
    float run = 0.f;
    for (int cb = 0; cb < 256; cb += 16) { bf16 s[16]; float d[16];
#pragma unroll
        for (int i = 0; i < 16; ++i) { s[i] = ST[(size_t)(cb + i) * 131072]; d[i] = DA[(size_t)(cb + i) * 64 * 16]; }
#pragma unroll
        for (int i = 0; i < 16; ++i) { if (!DUMMY) ST[(size_t)(cb + i) * 131072] = f2bf(run); run = run * expf(d[i]) + bf1(s[i]); } }
    if (DUMMY) WSP(float, WS_R + 386 * MiB)[e] = run;
}

template <bool DUMMY = false> __device__ __forceinline__ void ssd3_chunk(Frame& F, int l, int c) {
    const bf16* P = WSP(bf16, WS_PROJ); bf16* Y = WSP(bf16, WS_YCAT); bf16* YO = DUMMY ? WSP(bf16, WS_PROJ) : Y; const int yo_pitch = DUMMY ? PW : YW, yo_col = DUMMY ? 0 : 512; const bf16* CCp = WSP(bf16, WS_CC); const float* DACS = WSP(float, WS_DACS);
    const int fr = F.lane & 15, fq = F.lane >> 4, wave = F.wave, mi = wave & 3, t = 64 * c + 16 * mi + fr;
    for (int gx = 0; gx < 2; ++gx) {
        const int g = 2 * (wave >> 2) + gx;
        bf16x8 cf[4];
#pragma unroll
        for (int kk = 0; kk < 4; ++kk) cf[kk] = gfrag(CCp + (size_t)t * 512 + g * 128 + 32 * kk + 8 * fq);
        f32x4 y[4][4];
#pragma unroll
        for (int hl = 0; hl < 4; ++hl) { const bf16* HI = WSP(bf16, WS_STATES) + ((size_t)c * 16 + 4 * g + hl) * 8192 + (size_t)fr * 128 + 8 * fq;
            bf16x8 hq[4][4];
#pragma unroll
            for (int pi = 0; pi < 4; ++pi)
#pragma unroll
                for (int kk = 0; kk < 4; ++kk) hq[pi][kk] = gfrag(HI + (size_t)(16 * pi) * 128 + 32 * kk);
#pragma unroll
            for (int pi = 0; pi < 4; ++pi) { y[hl][pi] = (f32x4){0.f, 0.f, 0.f, 0.f};
#pragma unroll
                for (int kk = 0; kk < 4; ++kk) MMA16(y[hl][pi], hq[pi][kk], cf[kk]); }
            asm volatile("" ::: "memory"); }
        float sq = 0.f;
#pragma unroll
        for (int hl = 0; hl < 4; ++hl) { const int hh = 4 * g + hl; const float e = expf(DACS[(size_t)t * 16 + hh]);
#pragma unroll
            for (int pi = 0; pi < 4; ++pi) { const int ch = hh * 64 + 16 * pi + 4 * fq; const u32x2 yd = ld8(Y + (size_t)t * YW + 512 + ch), z = ld8(P + (size_t)t * PW + 1536 + ch);
                f32x4 v; v[0] = (bflo(yd.x) + e * y[hl][pi][0]) * silu_f(bflo(z.x)); v[1] = (bfhi(yd.x) + e * y[hl][pi][1]) * silu_f(bfhi(z.x));
                v[2] = (bflo(yd.y) + e * y[hl][pi][2]) * silu_f(bflo(z.y)); v[3] = (bfhi(yd.y) + e * y[hl][pi][3]) * silu_f(bfhi(z.y));
                y[hl][pi] = v; sq += (v[0] * v[0] + v[1] * v[1]) + (v[2] * v[2] + v[3] * v[3]); }
            asm volatile("" ::: "memory"); }
        sq += __shfl_xor(sq, 16); sq += __shfl_xor(sq, 32);
        const float rstd = 1.0f / sqrtf(sq * (1.f / 256.f) + EPS);
#pragma unroll
        for (int hl = 0; hl < 4; ++hl)
#pragma unroll
            for (int pi = 0; pi < 4; ++pi) { const int ch = (4 * g + hl) * 64 + 16 * pi + 4 * fq; const f32x4 ng = *(const f32x4*)(F.in[10] + (size_t)l * 1024 + ch); const f32x4 v = y[hl][pi] * rstd * ng;
                u32x2 w; w.x = cvt_pk_bf16(v[0], v[1]); w.y = cvt_pk_bf16(v[2], v[3]); *(u32x2*)(YO + (size_t)t * yo_pitch + yo_col + ch) = w; }
    }
}
struct Args { const float* in[31]; float* out; unsigned char* ws; int ph_lo, ph_hi; };
constexpr int PH_PER_LAYER = 12, N_PHASES = 2 + 2 * PH_PER_LAYER;

#ifndef PMASK
#define PMASK 0x3fff
#endif
#define IN(k) (lo <= (k) && (k) < hi)
#define EN(b) ((PMASK >> (b)) & 1)
#ifndef REPMASK
#define REPMASK 0
#endif
#define NREP(b) (((REPMASK >> (b)) & 1) ? 2 : 1)
#define PHASE_BEGIN() do { int _t = threadIdx.x; asm volatile("" : "+v"(_t)); F.tid = _t; F.lane = _t & 63; DG_START(); } while (0)
#ifdef REPBAR
#define REPEAT(b, ...) do { _Pragma("unroll") for (int _r = 0; _r < NREP(b); ++_r) { if (_r) { xcd_barrier(bar); PHASE_BEGIN(); } __VA_ARGS__; } } while (0)
#else
#define REPEAT(b, ...) do { _Pragma("unroll") for (int _r = 0; _r < NREP(b); ++_r) { __VA_ARGS__; } } while (0)
#endif
#define REPEAT1(b, ...) do { _Pragma("unroll") for (int _r = 0; _r < NREP(b); ++_r) { PHASE_BEGIN(); __VA_ARGS__; } } while (0)
#define SEAM(k) do { DG_STOP(k); if (IN((k) + 1) && MK_N_LAUNCHES == 1) { DG_START(); xcd_barrier(bar); DG_STOP(26); } } while (0)
template <int l> __device__ __forceinline__ void layer_phases(Frame& F, const XcdBarrier& bar, const int lo, const int hi) {
    const int gw = F.bid * NWAVES + F.wave, NGW = F.G * NWAVES;
    LAS unsigned char* ring = F.lds;
        const int pb = 1 + PH_PER_LAYER * l;
        const float* xin = (l == 0) ? F.in[0] : WSP(float, WS_XC);
        const bf16* W1T = WSP(bf16, WS_W1T) + (size_t)l * 10240 * D;
        if (EN(1) && IN(pb + 0) && l == 1) { PHASE_BEGIN(); rmsnorm_phase(F, xin, F.in[1] + D, WSP(bf16, WS_H)); SEAM(pb + 0); }
        if (EN(2) && IN(pb + 1)) { PHASE_BEGIN();
            pg8::DenseSched S; S.init(WSP(bf16, WS_H), W1T, L, PW, D, F.G, F.bid);
            pg8::EpiBf16Act E{WSP(bf16, WS_PROJ), PW, 18, 22, 0};
            REPEAT(2, pg8::gemm_phase<pg8::EpiBf16Act, pg8::DenseSched, true, false>(ring, D, S, E));
            SEAM(pb + 1);
        }
        if (EN(3) && IN(pb + 2)) { PHASE_BEGIN();
#ifndef MIXMASK
#define MIXMASK 15
#endif
            #ifndef SSD1MODE
#define SSD1MODE 0
#endif
#ifndef MIXREP
#define MIXREP 15
#endif
            REPEAT1(3, const int mm = (_r == 0) ? 15 : MIXREP; if (mm & 1) { DG_START(); if (_r == 0) ssd1_chunk<0>(F, l, F.bid); else ssd1_chunk<SSD1MODE>(F, l, F.bid);
#ifndef SSD1PROBE
                    DG_STOP(27);
#endif
                }
#ifndef SSD1PROBE
                if (mm & 2) { DG_START(); mixer_c(F, l, F.bid >> 1, F.bid & 1); DG_STOP(28); } if (mm & 4) { DG_START(); mixer_d(F, l, F.bid); DG_STOP(29); } if (mm & 8) { DG_START(); mixer_a(F, l, F.bid); DG_STOP(30); }
#else
                if (mm & 2) mixer_c(F, l, F.bid >> 1, F.bid & 1); if (mm & 4) mixer_d(F, l, F.bid); if (mm & 8) mixer_a(F, l, F.bid);
#endif
 __syncthreads());
            SEAM(pb + 2);
        }
        if (EN(4) && IN(pb + 3)) { PHASE_BEGIN(); if (NREP(4) == 2) { scan_phase<true>(F); PHASE_BEGIN(); } scan_phase<false>(F); SEAM(pb + 3); }
        if (EN(5) && IN(pb + 4)) { PHASE_BEGIN(); if (NREP(5) == 2) { ssd3_chunk<true>(F, l, F.bid); PHASE_BEGIN(); } ssd3_chunk<false>(F, l, F.bid); SEAM(pb + 4); }
        if (EN(6) && IN(pb + 5)) { PHASE_BEGIN();
            pg8::DenseSched S; S.init(WSP(bf16, WS_H), W1T + (size_t)PW * D, L, GW, D, F.G, F.bid);
            pg8::EpiBf16Act E{WSP(bf16, WS_GATES), GW, 0, 0, 1};
            REPEAT(6, pg8::gemm_phase<pg8::EpiBf16Act, pg8::DenseSched, true, false>(ring, D, S, E));
            SEAM(pb + 5);
        }
        if (EN(7) && IN(pb + 6)) { PHASE_BEGIN();
            pg8::DenseSched S; S.init(WSP(bf16, WS_YCAT), WSP(bf16, WS_BRT) + (size_t)l * D * YW, L, D, YW, F.G, F.bid);
            pg8::EpiMerge E{WSP(bf16, WS_GATES), WSP(bf16, WS_MERGED)};
            REPEAT(7, pg8::gemm_phase<pg8::EpiMerge, pg8::DenseSched, false, false>(ring, YW, S, E));
            SEAM(pb + 6);
        }
        if (EN(8) && IN(pb + 7)) { PHASE_BEGIN();
            pg8::DenseSched S; S.init(WSP(bf16, WS_MERGED), WSP(bf16, WS_OUTT) + (size_t)l * D * D, L, D, D, F.G, F.bid);
            pg8::EpiResid E{xin, WSP(float, WS_XC), D};
            pg8::gemm_phase<pg8::EpiResid, pg8::DenseSched, false, false>(ring, D, S, E);
            SEAM(pb + 7);
        }
        if (EN(9) && IN(pb + 8)) { PHASE_BEGIN();
            REPEAT(9, if (l == 0) rmsnorm_phase(F, WSP(float, WS_XC), F.in[22], WSP(bf16, WS_H2)); else { route_phase(F, WSP(float, WS_XC), F.in[22] + D, WSP(unsigned char, WS_H2), F.in[26]); __syncthreads(); convert_moe_weights(F, gw, NGW); __syncthreads(); });
            SEAM(pb + 8);
        }
        if (EN(10) && IN(pb + 9) && l == 1) { PHASE_BEGIN(); assign_phase(F); SEAM(pb + 9); }
        if (EN(11) && IN(pb + 10)) { PHASE_BEGIN();
            if (l == 0) {
                pg8::DenseSched S; S.init(WSP(bf16, WS_H2), WSP(bf16, WS_UPT), L, 2 * DFF, D, F.G, F.bid);
                pg8::EpiSwiglu E{WSP(bf16, WS_ACT), DFF};
                REPEAT(11, pg8::gemm_phase<pg8::EpiSwiglu, pg8::DenseSched, true, false>(ring, D, S, E));
            } else {
                MoeUpSched S; S.o.init(__builtin_amdgcn_readfirstlane(WSP(int, WS_ROUTE + RT_NT)[0]), 2 * DFE / 256, F.G, F.bid); S.A = (const char*)WSP(bf16, WS_H2); S.Bt = (const char*)WSP(bf16, WS_MOEUP);
                S.tile_e = WSP(int, WS_ROUTE + RT_TILEE); S.rowidx = WSP(int, WS_ROUTE + RT_ROWIDX);
                pg8::EpiSwigluF8 E{WSP(unsigned char, WS_ACTM), DFE, 1.f / MOE_UP_WSCALE};
                REPEAT(11, pg8::gemm_phase<pg8::EpiSwigluF8, MoeUpSched, true, true, 1>(ring, D, S, E));
            }
            SEAM(pb + 10);
        }
        if (EN(12) && IN(pb + 11)) { PHASE_BEGIN();
            if (l == 0) {
                pg8::DenseSched S; S.init(WSP(bf16, WS_ACT), WSP(bf16, WS_DNT), L, D, DFF, F.G, F.bid);
                pg8::EpiResid E{WSP(float, WS_XC), WSP(float, WS_XC), D};
                pg8::gemm_phase<pg8::EpiResid, pg8::DenseSched, false, false>(ring, DFF, S, E);
            } else {
                MoeDnSched S; S.o.init(__builtin_amdgcn_readfirstlane(WSP(int, WS_ROUTE + RT_NT)[0]), D / 256, F.G, F.bid); S.A = (const char*)WSP(bf16, WS_ACTM); S.Bt = (const char*)WSP(bf16, WS_MOEDN); S.tile_e = WSP(int, WS_ROUTE + RT_TILEE);
                pg8::EpiBf16Scale E{WSP(bf16, WS_YBUF), D, 1.f / MOE_DN_WSCALE};
                REPEAT(12, pg8::gemm_phase<pg8::EpiBf16Scale, MoeDnSched, true, false, 1>(ring, DFE, S, E));
            }
            SEAM(pb + 11);
        }

}
__global__ void __launch_bounds__(NTHR, 2) fwd_kernel(Args args) {
    extern __shared__ __attribute__((aligned(16))) unsigned char lds_raw[];
    Frame F;
    F.lds = (LAS unsigned char*)lds_raw;
    F.MISC = (volatile LAS unsigned*)(F.lds + MISC_OFF);
    F.tid = threadIdx.x; F.lane = F.tid & 63; F.wave = __builtin_amdgcn_readfirstlane(F.tid >> 6);
    F.G = gridDim.x; F.bid = blockIdx.x;
    F.ws = args.ws; F.ctl = (unsigned*)(args.ws + WS_CTL); F.in = args.in; F.out = args.out;
    for (int u = F.tid; u < (LDS_BYTES - MISC_OFF) / 4; u += NTHR) ((LAS unsigned*)(F.lds + MISC_OFF))[u] = 0u;
    __syncthreads();
    XcdBarrier bar; bar.bar = F.ctl + CW_BAR; bar.x = 0; bar.st = nullptr;
    if (MK_N_LAUNCHES == 1) bar = xcd_barrier_post(F.ctl + CW_BAR, F.MISC + 8);
    const int lo = args.ph_lo, hi = args.ph_hi;
    const int gw = F.bid * NWAVES + F.wave, NGW = F.G * NWAVES;
    LAS unsigned char* ring = F.lds;

    if (EN(0) && IN(0)) { PHASE_BEGIN();
        REPEAT(0, convert_layer_weights(F, 0, gw, NGW); convert_layer_weights(F, 1, gw, NGW); convert_ffn_weights(F, gw, NGW); rmsnorm_phase(F, F.in[0], F.in[1], WSP(bf16, WS_H)); __syncthreads());
        SEAM(0);
#ifdef EXTRA_BARS
        for (int i = 0; i < EXTRA_BARS; ++i) xcd_barrier(bar);
#endif
    }
#ifndef LMASK
#define LMASK 3
#endif
    if (LMASK & 1) layer_phases<0>(F, bar, lo, hi);
    if (LMASK & 2) layer_phases<1>(F, bar, lo, hi);
    if (EN(13) && IN(N_PHASES - 1)) { PHASE_BEGIN(); final_phase(F, WSP(float, WS_XC), WSP(bf16, WS_YBUF), F.in[30], F.out); DG_STOP(25); }
    if (DG_ON && F.bid == 0 && threadIdx.x == 0) { const unsigned long long want = DG_ACC * DIAGK, t0 = __builtin_amdgcn_s_memrealtime(); while (__builtin_amdgcn_s_memrealtime() - t0 < want) __builtin_amdgcn_s_sleep(8); }
#undef IN
#undef SEAM
}

extern "C" void kernel_launch(void* const* d_in, const int* in_sizes, int n_in, void* d_out, int out_size, void* d_ws, size_t ws_size, hipStream_t stream) {
    static int grid = 0;
    if (grid == 0) {
        if (n_in != 31 || in_sizes[0] != L * D || out_size != L * D || ws_size < WS_END) { fprintf(stderr, "kernel_launch: unexpected problem (n_in %d, out %d, ws %zu); nothing launched\n", n_in, out_size, ws_size); grid = -1; return; }
        int dev = 0, cus = 0, per_cu = 0;
        if (hipGetDevice(&dev) != hipSuccess || hipDeviceGetAttribute(&cus, hipDeviceAttributeMultiprocessorCount, dev) != hipSuccess) { grid = -1; return; }
        if (hipFuncSetAttribute((const void*)fwd_kernel, hipFuncAttributeMaxDynamicSharedMemorySize, LDS_BYTES) != hipSuccess) { fprintf(stderr, "kernel_launch: hipFuncSetAttribute failed\n"); grid = -1; return; }
        if (hipOccupancyMaxActiveBlocksPerMultiprocessor(&per_cu, (const void*)fwd_kernel, NTHR, LDS_BYTES) != hipSuccess || per_cu < 1) { fprintf(stderr, "kernel_launch: occupancy query reports %d workgroups per CU\n", per_cu); (void)hipGetLastError(); grid = -1; return; }
        if (cus != 256) { fprintf(stderr, "kernel_launch: built for 256 CUs, found %d\n", cus); grid = -1; return; }
        grid = 256;
    }
    if (grid < 0) return;
    if (hipMemsetAsync((char*)d_ws + WS_CTL, 0, CTL_ZERO_BYTES, stream) != hipSuccess) return;
    Args a{};
    for (int i = 0; i < 31; ++i) a.in[i] = (const float*)d_in[i];
    a.out = (float*)d_out; a.ws = (unsigned char*)d_ws;
    if (MK_N_LAUNCHES == 1) { a.ph_lo = 0; a.ph_hi = N_PHASES; hipLaunchKernelGGL(fwd_kernel, dim3(grid), dim3(NTHR), LDS_BYTES, stream, a); }
    else for (int p = 0; p < N_PHASES; ++p) {
        if (p == 1 || p == 1 + 9) continue;
        a.ph_lo = p; a.ph_hi = p + 1; hipLaunchKernelGGL(fwd_kernel, dim3(grid), dim3(NTHR), LDS_BYTES, stream, a);
    }
}
```
